# Optimizing an MI355X kernel written in HIP

```python
import jax, jax.numpy as jnp
from jax import lax
import numpy as np

D_MODEL = 1024
BATCH = 8
SEQ = 8192
DEPTH = 4

HEAD_DIM = 64
EPS = 1e-6
A_Q_HEADS = 12
A_KV_HEADS = 2
A_GROUP = A_Q_HEADS // A_KV_HEADS
WINDOW = 128
A_Q_W = A_Q_HEADS * HEAD_DIM
A_KV_W = A_KV_HEADS * HEAD_DIM
B_GROUPS = 6
B_GROUP_DIM = 128
B_WIDTH = B_GROUPS * B_GROUP_DIM
CHUNK = 128
N_MEM = 256
MEM_HEADS = 4
MEM_WIDTH = MEM_HEADS * HEAD_DIM
MIX_WIDTH = A_Q_W + MEM_WIDTH
A_IN = A_Q_W + 2 * A_KV_W + MEM_WIDTH
B_IN = 2 * B_WIDTH + MEM_WIDTH
D_FF = -(-8 * D_MODEL // (3 * 256)) * 256
N_A = (DEPTH + 1) // 2
N_B = DEPTH // 2

kernel_name = "hybrid_swa_sink_gmlp_memxattn_trunk"


def rms_norm(x, g):
    xf = x.astype(jnp.float32)
    y = xf * lax.rsqrt(jnp.mean(xf * xf, axis=-1, keepdims=True) + EPS)
    return (y * g.astype(jnp.float32)).astype(x.dtype)


def sliding_window_attention(q, k, v, sinks):
    b, s, _, hd = q.shape
    nb = s // WINDOW
    qb = q.reshape(b, nb, WINDOW, A_KV_HEADS, A_GROUP, hd)

    def with_prev(t):
        tb = t.reshape(b, nb, WINDOW, A_KV_HEADS, hd)
        prev = jnp.pad(tb[:, :-1], ((0, 0), (1, 0), (0, 0), (0, 0), (0, 0)))
        return jnp.concatenate([prev, tb], axis=2)

    kb, vb = with_prev(k), with_prev(v)
    scores = jnp.einsum('bnqhgd,bnkhd->bnhgqk', qb, kb).astype(jnp.float32) * (hd ** -0.5)
    qi = jnp.arange(WINDOW)[:, None]
    kj = jnp.arange(2 * WINDOW)[None, :]
    rel = qi + WINDOW - kj
    band = (rel >= 0) & (rel < WINDOW)
    not_pad = (jnp.arange(nb)[:, None, None] > 0) | (kj[None] >= WINDOW)
    mask = band[None] & not_pad
    scores = jnp.where(mask[None, :, None, None], scores, -jnp.inf)
    sink = sinks.astype(jnp.float32).reshape(A_KV_HEADS, A_GROUP)[None, None, :, :, None, None]
    m = jnp.maximum(jnp.max(scores, axis=-1, keepdims=True), sink)
    e = jnp.exp(scores - m)
    p = e / (jnp.sum(e, axis=-1, keepdims=True) + jnp.exp(sink - m))
    o = jnp.einsum('bnhgqk,bnkhd->bnqhgd', p.astype(v.dtype), vb)
    return o.reshape(b, s, A_Q_HEADS * hd)


def chunked_spatial_gating(z, w_s, b_s, ln_g, ln_b):
    b, s, _ = z.shape
    u, v = jnp.split(z, 2, axis=-1)
    v = v.reshape(b, s // CHUNK, CHUNK, B_GROUPS, B_GROUP_DIM)
    vf = v.astype(jnp.float32)
    mu = jnp.mean(vf, axis=-1, keepdims=True)
    var = jnp.mean(jnp.square(vf - mu), axis=-1, keepdims=True)
    vn = ((vf - mu) * lax.rsqrt(var + EPS) * ln_g.astype(jnp.float32) + ln_b.astype(jnp.float32)).astype(z.dtype)
    causal = jnp.tril(jnp.ones((CHUNK, CHUNK), dtype=bool))
    w = jnp.where(causal[None], w_s, jnp.zeros_like(w_s)).astype(vn.dtype)
    sv = jnp.einsum('gts,bnsgd->bntgd', w, vn) + b_s.T.astype(vn.dtype)[None, None, :, :, None]
    return u * sv.reshape(b, s, B_WIDTH).astype(z.dtype)


def memory_attention(q_mem, mem_n, w_kv):
    b, nm, _ = mem_n.shape
    kv = mem_n @ w_kv
    k, v = jnp.split(kv, 2, axis=-1)
    k = k.reshape(b, nm, MEM_HEADS, HEAD_DIM)
    v = v.reshape(b, nm, MEM_HEADS, HEAD_DIM)
    s = jnp.einsum('bshd,bmhd->bhsm', q_mem, k).astype(jnp.float32) * (HEAD_DIM ** -0.5)
    p = jax.nn.softmax(s, axis=-1).astype(v.dtype)
    o = jnp.einsum('bhsm,bmhd->bshd', p, v)
    return o.reshape(q_mem.shape[0], q_mem.shape[1], MEM_WIDTH)


def setup_inputs(seed: int = 0) -> dict:
    key = jax.random.key(seed)
    ks = jax.random.split(key, 20)
    f32 = jnp.float32

    def nrm(k, shape, fan_in):
        return jax.random.normal(k, shape, f32) * (fan_in ** -0.5)

    def gain(k, shape):
        return 1.0 + 0.05 * jax.random.normal(k, shape, f32)

    return {
        "x": jax.random.normal(ks[0], (BATCH, SEQ, D_MODEL), f32),
        "mem": jax.random.normal(ks[1], (BATCH, N_MEM, D_MODEL), f32),
        "mem_norm_g": gain(ks[2], (D_MODEL,)),
        "mix_norm_g": gain(ks[3], (DEPTH, D_MODEL)),
        "ffn_norm_g": gain(ks[4], (DEPTH, D_MODEL)),
        "final_norm_g": gain(ks[5], (D_MODEL,)),
        "a_w_in": nrm(ks[6], (N_A, D_MODEL, A_IN), D_MODEL),
        "a_sinks": 0.5 * jax.random.normal(ks[7], (N_A, A_Q_HEADS), f32),
        "a_w_out": nrm(ks[8], (N_A, MIX_WIDTH, D_MODEL), MIX_WIDTH),
        "b_w_in": nrm(ks[9], (N_B, D_MODEL, B_IN), D_MODEL),
        "b_w_s": nrm(ks[10], (N_B, B_GROUPS, CHUNK, CHUNK), CHUNK),
        "b_bias_s": 1.0 + 0.05 * jax.random.normal(ks[11], (N_B, B_GROUPS, CHUNK), f32),
        "b_ln_g": gain(ks[12], (N_B, B_GROUPS, B_GROUP_DIM)),
        "b_ln_b": 0.02 * jax.random.normal(ks[13], (N_B, B_GROUPS, B_GROUP_DIM), f32),
        "b_w_out": nrm(ks[14], (N_B, MIX_WIDTH, D_MODEL), MIX_WIDTH),
        "w_mem_kv": nrm(ks[15], (DEPTH, D_MODEL, 2 * MEM_WIDTH), D_MODEL),
        "w_gate_up": nrm(ks[16], (DEPTH, D_MODEL, 2 * D_FF), D_MODEL),
        "w_down": nrm(ks[17], (DEPTH, D_FF, D_MODEL), D_FF),
    }


def reference(x, mem, mem_norm_g, mix_norm_g, ffn_norm_g, final_norm_g,
              a_w_in, a_sinks, a_w_out,
              b_w_in, b_w_s, b_bias_s, b_ln_g, b_ln_b, b_w_out,
              w_mem_kv, w_gate_up, w_down):
    b, s, _ = x.shape
    mem_n = rms_norm(mem, mem_norm_g)
    h = x
    for i in range(DEPTH):
        j = i // 2
        xn = rms_norm(h, mix_norm_g[i])
        if i % 2 == 0:
            proj = xn @ a_w_in[j]
            q, k, v, q_mem = jnp.split(proj, [A_Q_W, A_Q_W + A_KV_W, A_Q_W + 2 * A_KV_W], axis=-1)
            mix = sliding_window_attention(
                q.reshape(b, s, A_Q_HEADS, HEAD_DIM),
                k.reshape(b, s, A_KV_HEADS, HEAD_DIM),
                v.reshape(b, s, A_KV_HEADS, HEAD_DIM),
                a_sinks[j])
            w_out = a_w_out[j]
        else:
            proj = xn @ b_w_in[j]
            z, q_mem = jnp.split(proj, [2 * B_WIDTH], axis=-1)
            mix = chunked_spatial_gating(jax.nn.gelu(z), b_w_s[j], b_bias_s[j], b_ln_g[j], b_ln_b[j])
            w_out = b_w_out[j]
        mem_out = memory_attention(q_mem.reshape(b, s, MEM_HEADS, HEAD_DIM), mem_n, w_mem_kv[i])
        h = h + jnp.concatenate([mix, mem_out.astype(mix.dtype)], axis=-1) @ w_out
        hn = rms_norm(h, ffn_norm_g[i])
        gate, up = jnp.split(hn @ w_gate_up[i], 2, axis=-1)
        h = h + (jax.nn.silu(gate) * up) @ w_down[i]
    return rms_norm(h, final_norm_g)
```

```cpp
#include <hip/hip_runtime.h>
#include <hip/hip_cooperative_groups.h>
#include <cstdio>
namespace cg = cooperative_groups;
namespace pg8 {
#define PG8_LAS __attribute__((address_space(3)))
typedef unsigned short bf16_t;
typedef short bf16x8 __attribute__((ext_vector_type(8)));
typedef float f32x4 __attribute__((ext_vector_type(4)));
typedef unsigned u32x4 __attribute__((ext_vector_type(4)));
constexpr int BM = 256, BK = 64, HALF = 128, HTB = HALF * BK * 2  , STAGE_BYTES = 8 * HTB, NXCD = 8, WGM = 8;

__host__ __device__ __forceinline__ int lds_byte(int r, int c) { const int st = (r >> 4) * 2 + (c >> 5), rr = r & 15, cc = c & 31, ob = rr * 64 + cc * 2; return st * 1024 + (ob ^ (((ob >> 9) & 1) << 5)); }
__host__ __device__ __forceinline__ void stage_rc(int b, int& R, int& C) { const int st = b / 1024, sb = b % 1024, swz = sb ^ (((sb >> 9) & 1) << 5); R = (st >> 1) * 16 + swz / 64; C = (st & 1) * 32 + (swz % 64) / 2; }
__host__ __device__ __forceinline__ int perm32(int rho) { const int n = rho >> 4, i = rho & 15; return 8 * (i >> 2) + 4 * n + (i & 3); }
struct Unit { int pm, pn; };
struct Gemm { const bf16_t* A; const bf16_t* Bt; int M, N, K; };
struct StaticOrder {
    int nM, nN, nwg, G, c;
    __host__ __device__ void init(int M, int N, int G_, int c_) { nM = M / BM; nN = N / BM; nwg = nM * nN; G = G_; c = c_; }
    __host__ __device__ bool next(int i, Unit& u) const {
        const long L = (long)i * G + c; if (L >= nwg) return false;
        int wgid = (int)L; { const int q = nwg / NXCD, r = nwg % NXCD, xcd = wgid % NXCD, off = wgid / NXCD; wgid = (xcd < r ? xcd * (q + 1) : r * (q + 1) + (xcd - r) * q) + off; }
        const int nig = WGM * nN, gid = wgid / nig, fm = gid * WGM, gsz = (nM - fm) < WGM ? (nM - fm) : WGM;
        u.pm = fm + ((wgid % nig) % gsz); u.pn = (wgid % nig) / gsz; return true;
    }
    __device__ __forceinline__ void a_ready(const Unit&) const {}
    __device__ __forceinline__ void done(const Unit&) const {}
};
typedef float f32x2_t __attribute__((ext_vector_type(2)));
typedef __bf16 bf16x2_t __attribute__((ext_vector_type(2)));
__device__ __forceinline__ unsigned cvt_pk_bf16(float lo, float hi) { const f32x2_t v = {lo, hi}; const bf16x2_t b = __builtin_convertvector(v, bf16x2_t); return __builtin_bit_cast(unsigned, b); }
template <class Epi, class Sched, bool STAMP = false>
__device__ __forceinline__ void gemm_phase(PG8_LAS unsigned char* lds, const Gemm g, const Sched& S, const Epi& E, unsigned long long* stamps) {
    int tid_ = threadIdx.x; asm volatile("" : "+v"(tid_));
    const int tid = tid_, wid = __builtin_amdgcn_readfirstlane(tid >> 6), lane = tid & 63, wr = wid >> 2, wc = wid & 3, fr = lane & 15, fq = lane >> 4;
    const int K = g.K, nt = K / BK;
    int ts_lo = 0, ts_hi = 0, nts = 0; const unsigned long long rt_entry = STAMP ? (unsigned long long)wall_clock64() : 0ull;
#define PG8_STAMP() do { if (STAMP && wid == 0 && nts < 64) { const unsigned long long _c = (unsigned long long)clock64(); \
        ts_lo = (lane == nts) ? (int)(unsigned)_c : ts_lo; ts_hi = (lane == nts) ? (int)(unsigned)(_c >> 32) : ts_hi; ++nts; } } while (0)
    PG8_STAMP();
    unsigned voffA[2], voffB[2];
#pragma unroll
    for (int i = 0; i < 2; ++i) { int R, C; stage_rc(tid * 16 + i * 8192, R, C); const int Rb = Epi::PERM ? ((R & ~31) + perm32(R & 31)) : R;
        voffA[i] = (unsigned)(R * K + C) * 2u; voffB[i] = (unsigned)(Rb * K + C) * 2u; }
    const size_t kstep = (size_t)(BK * 2);
    const size_t hstep = (size_t)HALF * K * 2;
    const size_t tstep = 2 * hstep;
    const unsigned ldsw = (unsigned)wid * 1024u;
    const int aoff = lds_byte(wr * 64 + fr, fq * 8), boff = lds_byte(wc * 32 + fr, fq * 8);
#define PG8_SA(b, h) (((b) * 2 + (h)) * HTB)
#define PG8_SB(b, h) ((4 + (b) * 2 + (h)) * HTB)
#define PG8_STAGE(bufoff, gbase, voff) do { _Pragma("unroll") for (int _i = 0; _i < 2; ++_i) \
        __builtin_amdgcn_global_load_lds((const unsigned*)((const char*)(gbase) + (voff)[_i]), (PG8_LAS unsigned*)(lds + (bufoff) + ldsw + _i * 8192), 16, 0, 0); } while (0)
#define PG8_LDA(dst, b, h) do { _Pragma("unroll") for (int m = 0; m < 4; ++m) _Pragma("unroll") for (int k = 0; k < 2; ++k) dst[m][k] = *(const PG8_LAS bf16x8*)(lds + PG8_SA(b, h) + aoff + m * 2048 + k * 1024); } while (0)
#define PG8_LDB(dst, b, h) do { _Pragma("unroll") for (int n = 0; n < 2; ++n) _Pragma("unroll") for (int k = 0; k < 2; ++k) dst[n][k] = *(const PG8_LAS bf16x8*)(lds + PG8_SB(b, h) + boff + n * 2048 + k * 1024); } while (0)
#define PG8_MMA(ai, bj, At, Bt) do { __builtin_amdgcn_s_setprio(1); _Pragma("unroll") for (int m = 0; m < 4; ++m) _Pragma("unroll") for (int n = 0; n < 2; ++n) _Pragma("unroll") for (int k = 0; k < 2; ++k) \
        acc[ai][bj][m][n] = __builtin_amdgcn_mfma_f32_16x16x32_bf16(Bt[n][k], At[m][k], acc[ai][bj][m][n], 0, 0, 0); __builtin_amdgcn_s_setprio(0); } while (0)
#define PG8_WAIT_V(n) asm volatile("s_waitcnt vmcnt(" #n ")" ::: "memory")
#define PG8_WAIT_L(n) asm volatile("s_waitcnt lgkmcnt(" #n ")" ::: "memory")
#define PG8_BAR __builtin_amdgcn_s_barrier()
#define PG8_SCHED __builtin_amdgcn_sched_barrier(0)
    Unit cur, nxt; int ui = 0;
    if (!S.next(0, cur)) return;
    f32x4 acc[2][2][4][2];
#pragma unroll
    for (int a = 0; a < 2; ++a)
#pragma unroll
        for (int b = 0; b < 2; ++b)
#pragma unroll
            for (int m = 0; m < 4; ++m)
#pragma unroll
                for (int n = 0; n < 2; ++n) acc[a][b][m][n] = (f32x4){0.f, 0.f, 0.f, 0.f};
    bf16x8 At[4][2], B0[2][2], B1[2][2];
    const char* cA = (const char*)g.A + (size_t)cur.pm * tstep; const char* cB = (const char*)g.Bt + (size_t)cur.pn * tstep;
    S.a_ready(cur);
    PG8_STAGE(PG8_SB(0, 0), cB, voffB); PG8_STAGE(PG8_SA(0, 0), cA, voffA); PG8_STAGE(PG8_SB(0, 1), cB + hstep, voffB); PG8_STAGE(PG8_SA(0, 1), cA + hstep, voffA);
    if (wr == 1) PG8_BAR;
    PG8_WAIT_V(4); PG8_BAR;
    PG8_STAGE(PG8_SB(1, 0), cB + kstep, voffB); PG8_STAGE(PG8_SA(1, 0), cA + kstep, voffA); PG8_STAGE(PG8_SB(1, 1), cB + hstep + kstep, voffB);
    PG8_WAIT_V(6); PG8_BAR;
    PG8_STAMP();
    for (;;) {
        const bool has_next = S.next(ui + 1, nxt);
        const char* nA = has_next ? (const char*)g.A + (size_t)nxt.pm * tstep : cA; const char* nB = has_next ? (const char*)g.Bt + (size_t)nxt.pn * tstep : cB;
        for (int t = 0; t < nt; t += 2) {
            const bool last = (t == nt - 2);
            const char* a1 = cA + (size_t)(t + 1) * kstep;
            const char* a2 = last ? nA : cA + (size_t)(t + 2) * kstep; const char* b2 = last ? nB : cB + (size_t)(t + 2) * kstep;
            const char* a3 = a2 + kstep; const char* b3 = b2 + kstep;
            if (last && has_next) S.a_ready(nxt);
            PG8_LDB(B0, 0, 0); PG8_SCHED; PG8_LDA(At, 0, 0); PG8_STAGE(PG8_SA(1, 1), a1 + hstep, voffA);
            PG8_WAIT_L(8); PG8_BAR; PG8_WAIT_L(0); PG8_MMA(0, 0, At, B0); PG8_BAR; PG8_SCHED;
            PG8_LDB(B1, 0, 1); PG8_STAGE(PG8_SB(0, 0), b2, voffB);
            PG8_BAR; PG8_WAIT_L(0); PG8_MMA(0, 1, At, B1); PG8_BAR;
            PG8_LDA(At, 0, 1); PG8_STAGE(PG8_SA(0, 0), a2, voffA);
            PG8_BAR; PG8_WAIT_L(0); PG8_MMA(1, 0, At, B0); PG8_BAR; PG8_SCHED;
            PG8_STAGE(PG8_SB(0, 1), b2 + hstep, voffB);
            PG8_WAIT_V(6); PG8_BAR; PG8_MMA(1, 1, At, B1); PG8_BAR;
            PG8_LDB(B0, 1, 0); PG8_SCHED; PG8_LDA(At, 1, 0); PG8_STAGE(PG8_SA(0, 1), a2 + hstep, voffA);
            PG8_WAIT_L(8); PG8_BAR; PG8_WAIT_L(0); PG8_MMA(0, 0, At, B0); PG8_BAR; PG8_SCHED;
            PG8_LDB(B1, 1, 1); PG8_STAGE(PG8_SB(1, 0), b3, voffB);
            PG8_BAR; PG8_WAIT_L(0); PG8_MMA(0, 1, At, B1); PG8_BAR;
            PG8_LDA(At, 1, 1); PG8_STAGE(PG8_SA(1, 0), a3, voffA);
            PG8_BAR; PG8_WAIT_L(0); PG8_MMA(1, 0, At, B0); PG8_BAR; PG8_SCHED;
            PG8_STAGE(PG8_SB(1, 1), b3 + hstep, voffB);
            PG8_WAIT_V(6); PG8_BAR; PG8_MMA(1, 1, At, B1); PG8_BAR;
        }
        PG8_STAMP();
        if constexpr (!Epi::AFTER_DRAIN) { E(acc, cur, wr, wc, fr, fq); S.done(cur); }
        PG8_STAMP();
        if (!has_next) break;
#pragma unroll
        for (int a = 0; a < 2; ++a)
#pragma unroll
            for (int b = 0; b < 2; ++b)
#pragma unroll
                for (int m = 0; m < 4; ++m)
#pragma unroll
                    for (int n = 0; n < 2; ++n) acc[a][b][m][n] = (f32x4){0.f, 0.f, 0.f, 0.f};
        cur = nxt; cA = nA; cB = nB; ++ui;
    }
    PG8_WAIT_V(0);
    if (wr == 0) PG8_BAR;
    PG8_BAR;
    if constexpr (Epi::AFTER_DRAIN) { E.fused(acc, cur, wr, wc, fr, fq, lds, wid, lane); S.done(cur); }
    PG8_STAMP();
    if (STAMP && wid == 0) { stamps[lane] = lane < nts ? (((unsigned long long)(unsigned)ts_hi << 32) | (unsigned)ts_lo) : 0ull;
        if (lane == 62) stamps[62] = rt_entry; if (lane == 63) stamps[63] = (unsigned long long)wall_clock64(); }
#undef PG8_STAMP
#undef PG8_SA
#undef PG8_SB
#undef PG8_STAGE
#undef PG8_LDA
#undef PG8_LDB
#undef PG8_MMA
#undef PG8_WAIT_V
#undef PG8_WAIT_L
#undef PG8_BAR
#undef PG8_SCHED
}
}

using pg8::bf16_t; using pg8::bf16x8; using pg8::f32x4; using pg8::u32x4; using pg8::Unit; using pg8::cvt_pk_bf16;
#define LAS PG8_LAS
typedef short s16x4 __attribute__((ext_vector_type(4)));
typedef unsigned u32x2 __attribute__((ext_vector_type(2)));

constexpr int T_TOK = 65536, SEQ = 8192;
constexpr int A_IN = 1280, B_IN = 1792, DFF = 2816, GU_N = 5632;
constexpr float EPS = 1e-6f;
constexpr float SS_SCALE = 1048576.f, SS_INV = 1.f / (1048576.f * 1024.f);
constexpr int LDS_BYTES = 131072;
constexpr int NPH = 23;

constexpr size_t WS_WAIN  = 0;
constexpr size_t WS_WBIN  = WS_WAIN  + 2ull * 1280 * 1024 * 2;
constexpr size_t WS_WAOUT = WS_WBIN  + 2ull * 1792 * 1024 * 2;
constexpr size_t WS_WBOUT = WS_WAOUT + 2ull * 1024 * 1024 * 2;
constexpr size_t WS_WMKV  = WS_WBOUT + 2ull * 1024 * 1024 * 2;
constexpr size_t WS_WGU   = WS_WMKV  + 2048ull * 1024 * 2;
constexpr size_t WS_WDN   = WS_WGU   + 4ull * 5632 * 1024 * 2;
constexpr size_t WS_BWS   = WS_WDN   + 4ull * 1024 * 2816 * 2;
constexpr size_t WS_MEMN  = WS_BWS   + 2ull * 6 * 128 * 128 * 2;
constexpr size_t WS_MEMKV = WS_MEMN  + 2048ull * 1024 * 2;
constexpr size_t WS_SS    = WS_MEMKV + 2048ull * 2048 * 2;
constexpr size_t WS_H16   = WS_SS    + 9ull * 65536 * 8;
constexpr size_t WS_BIG   = WS_H16   + 65536ull * 1024 * 2;
constexpr size_t WS_MIX   = WS_BIG   + 65536ull * 1792 * 2;
constexpr size_t WS_END   = WS_BIG   + 65536ull * 2816 * 2;

struct Params { const float* in[18]; float* out; unsigned char* ws; int ph_lo, ph_hi; };

__device__ __forceinline__ float bf2f(unsigned short b) { return __uint_as_float(((unsigned)b) << 16); }
__device__ __forceinline__ float wave_sum(float v) {
#pragma unroll
    for (int o = 32; o; o >>= 1) v += __shfl_xor(v, o);
    return v;
}
__device__ __forceinline__ float gelu_t(float x) {
    const float u = 0.7978845608028654f * x * (1.f + 0.044715f * x * x);
    const float e = __builtin_amdgcn_exp2f(-2.885390081777927f * u);
    return x * __builtin_amdgcn_rcpf(1.f + e);
}

template <int MODE> struct EpiProj {
    static constexpr bool PERM = true, AFTER_DRAIN = false;
    bf16_t* O; int ldc; const unsigned long long* ss;
    __device__ __forceinline__ void operator()(const f32x4 (&acc)[2][2][4][2], const Unit& u, int wr, int wc, int fr, int fq) const {
        const int row0 = u.pm * 256 + wr * 64 + fr, col0 = u.pn * 256 + wc * 32 + 8 * fq;
        const bool act = (MODE == 1) && (u.pn < 6);
#pragma unroll
        for (int ai = 0; ai < 2; ++ai)
#pragma unroll
            for (int m = 0; m < 4; ++m) {
                const int row = row0 + ai * 128 + m * 16;
                float rs = 1.f; if (MODE != 2) rs = rsqrtf((float)ss[row] * SS_INV + EPS);
                bf16_t* rowp = O + (size_t)row * ldc + col0;
#pragma unroll
                for (int bj = 0; bj < 2; ++bj) {
                    f32x4 v0 = acc[ai][bj][m][0] * rs, v1 = acc[ai][bj][m][1] * rs;
                    if (act) {
#pragma unroll
                        for (int e = 0; e < 4; ++e) { v0[e] = gelu_t(v0[e]); v1[e] = gelu_t(v1[e]); }
                    }
                    u32x4 pk; pk[0] = cvt_pk_bf16(v0[0], v0[1]); pk[1] = cvt_pk_bf16(v0[2], v0[3]); pk[2] = cvt_pk_bf16(v1[0], v1[1]); pk[3] = cvt_pk_bf16(v1[2], v1[3]);
                    *(u32x4*)(rowp + bj * 128) = pk;
                }
            }
    }
};
struct EpiGateUp {
    static constexpr bool PERM = true, AFTER_DRAIN = false;
    bf16_t* O; const unsigned long long* ss;
    __device__ __forceinline__ void operator()(const f32x4 (&acc)[2][2][4][2], const Unit& u, int wr, int wc, int fr, int fq) const {
        const int row0 = u.pm * 256 + wr * 64 + fr, col0 = u.pn * 128 + wc * 16 + 4 * fq;
#pragma unroll
        for (int ai = 0; ai < 2; ++ai)
#pragma unroll
            for (int m = 0; m < 4; ++m) {
                const int row = row0 + ai * 128 + m * 16;
                const float rs = rsqrtf((float)ss[row] * SS_INV + EPS);
                bf16_t* rowp = O + (size_t)row * DFF + col0;
#pragma unroll
                for (int bj = 0; bj < 2; ++bj) {
                    const f32x4 g = acc[ai][bj][m][0] * rs, up = acc[ai][bj][m][1] * rs;
                    float o[4];
#pragma unroll
                    for (int e = 0; e < 4; ++e) o[e] = g[e] * up[e] * __builtin_amdgcn_rcpf(1.f + __builtin_amdgcn_exp2f(-1.4426950408889634f * g[e]));
                    u32x2 pk; pk[0] = cvt_pk_bf16(o[0], o[1]); pk[1] = cvt_pk_bf16(o[2], o[3]);
                    *(u32x2*)(rowp + bj * 64) = pk;
                }
            }
    }
};
struct EpiRes {
    static constexpr bool PERM = false, AFTER_DRAIN = false;
    const float* hin; float* hout; bf16_t* h16; unsigned long long* ssout;
    __device__ __forceinline__ void operator()(const f32x4 (&acc)[2][2][4][2], const Unit& u, int wr, int wc, int fr, int fq) const {
        const int row0 = u.pm * 256 + wr * 64 + fr, col0 = u.pn * 256 + wc * 32 + 4 * fq;
#pragma unroll
        for (int ai = 0; ai < 2; ++ai)
#pragma unroll
            for (int m = 0; m < 4; ++m) {
                const int row = row0 + ai * 128 + m * 16;
                const float* ip = hin + (size_t)row * 1024 + col0; float* op = hout + (size_t)row * 1024 + col0; bf16_t* bp = h16 + (size_t)row * 1024 + col0;
                float sq = 0.f;
#pragma unroll
                for (int bj = 0; bj < 2; ++bj)
#pragma unroll
                    for (int n = 0; n < 2; ++n) {
                        const int c = bj * 128 + n * 16;
                        const f32x4 v = *(const f32x4*)(ip + c) + acc[ai][bj][m][n];
                        *(f32x4*)(op + c) = v;
                        u32x2 pk; pk[0] = cvt_pk_bf16(v[0], v[1]); pk[1] = cvt_pk_bf16(v[2], v[3]);
                        *(u32x2*)(bp + c) = pk;
                        sq += v[0] * v[0] + v[1] * v[1] + v[2] * v[2] + v[3] * v[3];
                    }
                sq += __shfl_xor(sq, 16); sq += __shfl_xor(sq, 32);
                if (fq == 0) atomicAdd(ssout + row, (unsigned long long)(sq * SS_SCALE));
            }
    }
};

template <class Epi> __device__ __forceinline__ void run_gemm(LAS unsigned char* lds, const bf16_t* A, const bf16_t* Bt, int M, int N, int K, const Epi& E) {
    pg8::Gemm g; g.A = A; g.Bt = Bt; g.M = M; g.N = N; g.K = K;
    pg8::StaticOrder S; S.init(M, N, (int)gridDim.x, (int)blockIdx.x);
    pg8::gemm_phase<Epi, pg8::StaticOrder, false>(lds, g, S, E, nullptr);
}

__device__ __forceinline__ void conv_tile(const int tid, LAS float* t, const float* src, bf16_t* dst, int K, int N, const float* gain, int mode, int tile) {
    const int ntn = N >> 6, tk = tile / ntn, tn = tile - tk * ntn, k0 = tk * 64, n0 = tn * 64;
    {
        const int kr = tid >> 3, nc = (tid & 7) * 8;
        const float* s = src + (size_t)(k0 + kr) * N + n0 + nc;
        const f32x4 a = *(const f32x4*)s, b = *(const f32x4*)(s + 4);
        const float gs = gain ? gain[k0 + kr] : 1.f;
        LAS float* tp = t + kr * 65 + nc;
        tp[0] = a[0] * gs; tp[1] = a[1] * gs; tp[2] = a[2] * gs; tp[3] = a[3] * gs; tp[4] = b[0] * gs; tp[5] = b[1] * gs; tp[6] = b[2] * gs; tp[7] = b[3] * gs;
    }
    __syncthreads();
    {
        const int nr = tid >> 3, kc = (tid & 7) * 8, n = n0 + nr;
        float cs = 1.f;
        if (mode == 1 && (n < 768 || n >= 1024)) cs = 0.125f;
        if (mode == 2 && n >= 1536) cs = 0.125f;
        int drow = n;
        if (mode == 3) { if (n < DFF) drow = 8 * (n >> 2) + (n & 3); else { const int j = n - DFF; drow = 8 * (j >> 2) + 4 + (j & 3); } }
        float v[8];
#pragma unroll
        for (int e = 0; e < 8; ++e) v[e] = t[(kc + e) * 65 + nr] * cs;
        u32x4 pk; pk[0] = cvt_pk_bf16(v[0], v[1]); pk[1] = cvt_pk_bf16(v[2], v[3]); pk[2] = cvt_pk_bf16(v[4], v[5]); pk[3] = cvt_pk_bf16(v[6], v[7]);
        *(u32x4*)(dst + (size_t)drow * K + k0 + kc) = pk;
    }
    __syncthreads();
}
__device__ __forceinline__ void conv_job(const int tid, LAS float* t, const float* src, bf16_t* dst, int K, int N, const float* gain, int mode) {
    const int nt = (K >> 6) * (N >> 6);
    for (int tile = blockIdx.x; tile < nt; tile += gridDim.x) conv_tile(tid, t, src, dst, K, N, gain, mode, tile);
}

__device__ void prologue(const Params& p, LAS unsigned char* lds) {
    LAS float* t = (LAS float*)lds;
    unsigned char* ws = p.ws;
    int tid = threadIdx.x; asm volatile("" : "+v"(tid));
    for (int j = 0; j < 2; ++j) {
        conv_job(tid, t, p.in[6] + (size_t)j * 1024 * A_IN, (bf16_t*)(ws + WS_WAIN) + (size_t)j * A_IN * 1024, 1024, A_IN, p.in[3] + (2 * j) * 1024, 1);
        conv_job(tid, t, p.in[9] + (size_t)j * 1024 * B_IN, (bf16_t*)(ws + WS_WBIN) + (size_t)j * B_IN * 1024, 1024, B_IN, p.in[3] + (2 * j + 1) * 1024, 2);
        conv_job(tid, t, p.in[8] + (size_t)j * 1024 * 1024, (bf16_t*)(ws + WS_WAOUT) + (size_t)j * 1024 * 1024, 1024, 1024, nullptr, 0);
        conv_job(tid, t, p.in[14] + (size_t)j * 1024 * 1024, (bf16_t*)(ws + WS_WBOUT) + (size_t)j * 1024 * 1024, 1024, 1024, nullptr, 0);
    }
    for (int i = 0; i < 4; ++i) {
        conv_job(tid, t, p.in[15] + (size_t)i * 1024 * 512, (bf16_t*)(ws + WS_WMKV) + (size_t)i * 512 * 1024, 1024, 512, nullptr, 0);
        conv_job(tid, t, p.in[16] + (size_t)i * 1024 * GU_N, (bf16_t*)(ws + WS_WGU) + (size_t)i * GU_N * 1024, 1024, GU_N, p.in[4] + i * 1024, 3);
        conv_job(tid, t, p.in[17] + (size_t)i * DFF * 1024, (bf16_t*)(ws + WS_WDN) + (size_t)i * 1024 * DFF, DFF, 1024, nullptr, 0);
    }
    const int gtid = blockIdx.x * 512 + tid, gn = gridDim.x * 512;
    { const float* s = p.in[10]; bf16_t* d = (bf16_t*)(ws + WS_BWS);
      for (int i = gtid; i < 2 * 6 * 128 * 128; i += gn) { const int tt = (i >> 7) & 127, sidx = i & 127; const float v = (sidx <= tt) ? s[i] : 0.f; d[i] = (bf16_t)(cvt_pk_bf16(v, 0.f) & 0xffffu); } }
    { unsigned long long* ss = (unsigned long long*)(ws + WS_SS) + 65536;
      for (int i = gtid; i < 8 * 65536; i += gn) ss[i] = 0ull; }
    const int gw = gtid >> 6, nw = gn >> 6, lane = tid & 63;
    { const float* mem = p.in[1]; const float* g = p.in[2]; bf16_t* mn = (bf16_t*)(ws + WS_MEMN);
      for (int row = gw; row < 2048; row += nw) {
          f32x4 v[4]; float sq = 0.f;
#pragma unroll
          for (int i = 0; i < 4; ++i) { v[i] = *(const f32x4*)(mem + (size_t)row * 1024 + i * 256 + lane * 4); sq += v[i][0] * v[i][0] + v[i][1] * v[i][1] + v[i][2] * v[i][2] + v[i][3] * v[i][3]; }
          sq = wave_sum(sq); const float rs = rsqrtf(sq * (1.f / 1024.f) + EPS);
#pragma unroll
          for (int i = 0; i < 4; ++i) { const f32x4 gg = *(const f32x4*)(g + i * 256 + lane * 4); const f32x4 o = v[i] * rs * gg;
              u32x2 pk; pk[0] = cvt_pk_bf16(o[0], o[1]); pk[1] = cvt_pk_bf16(o[2], o[3]); *(u32x2*)(mn + (size_t)row * 1024 + i * 256 + lane * 4) = pk; }
      } }
    { const float* x = p.in[0]; bf16_t* h16 = (bf16_t*)(ws + WS_H16); unsigned long long* ss0 = (unsigned long long*)(ws + WS_SS);
      for (int row = gw; row < T_TOK; row += nw) {
          float sq = 0.f;
#pragma unroll
          for (int i = 0; i < 4; ++i) { const f32x4 v = *(const f32x4*)(x + (size_t)row * 1024 + i * 256 + lane * 4); sq += v[0] * v[0] + v[1] * v[1] + v[2] * v[2] + v[3] * v[3];
              u32x2 pk; pk[0] = cvt_pk_bf16(v[0], v[1]); pk[1] = cvt_pk_bf16(v[2], v[3]); *(u32x2*)(h16 + (size_t)row * 1024 + i * 256 + lane * 4) = pk; }
          sq = wave_sum(sq); if (lane == 0) ss0[row] = (unsigned long long)(sq * SS_SCALE);
      } }
}

constexpr int KSTR = 144, VSTR = 160, K_OFF = 0, V_OFF = 256 * KSTR;
__device__ __forceinline__ s16x4 tr_read(LAS unsigned char* a) { return __builtin_amdgcn_ds_read_tr16_b64_v4i16((LAS s16x4*)a); }

template <bool SWA> __device__ __forceinline__ void attn_item(const int tid, LAS unsigned char* lds, const bf16_t* Q, int ldq, const bf16_t* Kg, const bf16_t* Vg, int ldkv, bool zfirst, float sink, bf16_t* O) {
    const int wid = __builtin_amdgcn_readfirstlane(tid >> 6), lane = tid & 63, fr = lane & 15, fq = lane >> 4;
    __syncthreads();
#pragma unroll
    for (int i = 0; i < 4; ++i) {
        const int c = tid + 512 * i, row = c >> 3, ch = c & 7;
        u32x4 kv = (u32x4){0u, 0u, 0u, 0u}, vv = (u32x4){0u, 0u, 0u, 0u};
        if (!(zfirst && i < 2)) { kv = *(const u32x4*)(Kg + (long)row * ldkv + ch * 8); vv = *(const u32x4*)(Vg + (long)row * ldkv + ch * 8); }
        *(LAS u32x4*)(lds + K_OFF + row * KSTR + ch * 16) = kv;
        *(LAS u32x4*)(lds + V_OFF + row * VSTR + ch * 16) = vv;
    }
    const bf16_t* qp = Q + (long)(16 * wid + fr) * ldq + fq * 8;
    const bf16x8 q0 = *(const bf16x8*)qp, q1 = *(const bf16x8*)(qp + 32);
    __syncthreads();
    f32x4 s[16];
#pragma unroll
    for (int sub = 0; sub < 16; ++sub) {
        s[sub] = (f32x4){0.f, 0.f, 0.f, 0.f};
        const bf16x8 a0 = *(const LAS bf16x8*)(lds + K_OFF + (16 * sub + fr) * KSTR + fq * 16);
        const bf16x8 a1 = *(const LAS bf16x8*)(lds + K_OFF + (16 * sub + fr) * KSTR + 64 + fq * 16);
        s[sub] = __builtin_amdgcn_mfma_f32_16x16x32_bf16(a0, q0, s[sub], 0, 0, 0);
        s[sub] = __builtin_amdgcn_mfma_f32_16x16x32_bf16(a1, q1, s[sub], 0, 0, 0);
    }
    const int qi = 16 * wid + fr;
    float mx = SWA ? sink : -INFINITY;
#pragma unroll
    for (int sub = 0; sub < 16; ++sub)
#pragma unroll
        for (int j = 0; j < 4; ++j) {
            if (SWA) { const int kj = 16 * sub + 4 * fq + j; const bool ok = (kj > qi) && (kj <= qi + 128) && (!zfirst || kj >= 128); if (!ok) s[sub][j] = -INFINITY; }
            mx = fmaxf(mx, s[sub][j]);
        }
    mx = fmaxf(mx, __shfl_xor(mx, 16)); mx = fmaxf(mx, __shfl_xor(mx, 32));
    float sum = 0.f;
#pragma unroll
    for (int sub = 0; sub < 16; ++sub)
#pragma unroll
        for (int j = 0; j < 4; ++j) { const float e = __builtin_amdgcn_exp2f((s[sub][j] - mx) * 1.4426950408889634f); s[sub][j] = e; sum += e; }
    sum += __shfl_xor(sum, 16); sum += __shfl_xor(sum, 32);
    if (SWA) sum += __builtin_amdgcn_exp2f((sink - mx) * 1.4426950408889634f);
    const float inv = 1.f / sum;
    f32x4 o[4];
#pragma unroll
    for (int d = 0; d < 4; ++d) o[d] = (f32x4){0.f, 0.f, 0.f, 0.f};
    LAS unsigned char* vb = lds + V_OFF + (4 * fq + (fr >> 2)) * VSTR + (fr & 3) * 8;
#pragma unroll
    for (int kk = 0; kk < 8; ++kk) {
        const f32x4 p0 = s[2 * kk] * inv, p1 = s[2 * kk + 1] * inv;
        u32x4 pk; pk[0] = cvt_pk_bf16(p0[0], p0[1]); pk[1] = cvt_pk_bf16(p0[2], p0[3]); pk[2] = cvt_pk_bf16(p1[0], p1[1]); pk[3] = cvt_pk_bf16(p1[2], p1[3]);
        const bf16x8 pf = __builtin_bit_cast(bf16x8, pk);
#pragma unroll
        for (int d = 0; d < 4; ++d) {
            const s16x4 v1 = tr_read(vb + (32 * kk) * VSTR + d * 32), v2 = tr_read(vb + (32 * kk + 16) * VSTR + d * 32);
            const bf16x8 vf = __builtin_shufflevector(v1, v2, 0, 1, 2, 3, 4, 5, 6, 7);
            o[d] = __builtin_amdgcn_mfma_f32_16x16x32_bf16(vf, pf, o[d], 0, 0, 0);
        }
    }
    bf16_t* op = O + (long)(16 * wid + fr) * 1024 + 4 * fq;
#pragma unroll
    for (int d = 0; d < 4; ++d) { u32x2 pk; pk[0] = cvt_pk_bf16(o[d][0], o[d][1]); pk[1] = cvt_pk_bf16(o[d][2], o[d][3]); *(u32x2*)(op + 16 * d) = pk; }
}

__device__ __forceinline__ void mem_item(const int tid, const Params& p, LAS unsigned char* lds, int layer, const bf16_t* proj, int ldp, int qoff, int qb, int mh) {
    const int b = qb >> 6; const long tok0 = (long)qb * 128;
    const bf16_t* kv = (const bf16_t*)(p.ws + WS_MEMKV) + (long)b * 256 * 2048 + layer * 512 + mh * 64;
    attn_item<false>(tid, lds, proj + tok0 * ldp + qoff + mh * 64, ldp, kv, kv + 256, 2048, false, 0.f, (bf16_t*)(p.ws + WS_MIX) + tok0 * 1024 + 768 + mh * 64);
}

__device__ void mix_phase_a(const Params& p, LAS unsigned char* lds, int layer) {
    int tid = threadIdx.x; asm volatile("" : "+v"(tid));
    const int j = layer >> 1;
    const bf16_t* proj = (const bf16_t*)(p.ws + WS_BIG);
    const float* sinks = p.in[7] + j * 12;
    for (int item = blockIdx.x; item < 512 * 16; item += gridDim.x) {
        const int head = item & 15, qb = item >> 4;
        if (head < 12) {
            const long tok0 = (long)qb * 128; const int kvh = head / 6;
            const bf16_t* kp = proj + (tok0 - 128) * A_IN + 768 + kvh * 64;
            attn_item<true>(tid, lds, proj + tok0 * A_IN + head * 64, A_IN, kp, kp + 128, A_IN, (qb & 63) == 0, sinks[head], (bf16_t*)(p.ws + WS_MIX) + tok0 * 1024 + head * 64);
        } else mem_item(tid, p, lds, layer, proj, A_IN, 1024, qb, head - 12);
    }
}

constexpr int NSTR = 288;
__device__ __forceinline__ void gate_item(const int tid, const Params& p, LAS unsigned char* lds, int j, const bf16_t* proj, int cb, int g) {
    const int wid = __builtin_amdgcn_readfirstlane(tid >> 6), lane = tid & 63, fr = lane & 15, fq = lane >> 4;
    const long tok0 = (long)cb * 128;
    const float* lng = p.in[12] + (j * 6 + g) * 128; const float* lnb = p.in[13] + (j * 6 + g) * 128;
    __syncthreads();
#pragma unroll
    for (int i = 0; i < 4; ++i) {
        const int c = tid + 512 * i, row = c >> 4, ch = c & 15;
        const u32x4 raw = *(const u32x4*)(proj + (tok0 + row) * B_IN + 768 + 128 * g + ch * 8);
        float v[8];
#pragma unroll
        for (int e = 0; e < 4; ++e) { v[2 * e] = __uint_as_float(raw[e] << 16); v[2 * e + 1] = __uint_as_float(raw[e] & 0xffff0000u); }
        float sm = 0.f;
#pragma unroll
        for (int e = 0; e < 8; ++e) sm += v[e];
        sm += __shfl_xor(sm, 1); sm += __shfl_xor(sm, 2); sm += __shfl_xor(sm, 4); sm += __shfl_xor(sm, 8);
        const float mu = sm * (1.f / 128.f);
        float sq = 0.f;
#pragma unroll
        for (int e = 0; e < 8; ++e) { v[e] -= mu; sq += v[e] * v[e]; }
        sq += __shfl_xor(sq, 1); sq += __shfl_xor(sq, 2); sq += __shfl_xor(sq, 4); sq += __shfl_xor(sq, 8);
        const float rs = rsqrtf(sq * (1.f / 128.f) + EPS);
        const f32x4 g0 = *(const f32x4*)(lng + ch * 8), g1 = *(const f32x4*)(lng + ch * 8 + 4), b0 = *(const f32x4*)(lnb + ch * 8), b1 = *(const f32x4*)(lnb + ch * 8 + 4);
        u32x4 pk;
        pk[0] = cvt_pk_bf16(v[0] * rs * g0[0] + b0[0], v[1] * rs * g0[1] + b0[1]); pk[1] = cvt_pk_bf16(v[2] * rs * g0[2] + b0[2], v[3] * rs * g0[3] + b0[3]);
        pk[2] = cvt_pk_bf16(v[4] * rs * g1[0] + b1[0], v[5] * rs * g1[1] + b1[1]); pk[3] = cvt_pk_bf16(v[6] * rs * g1[2] + b1[2], v[7] * rs * g1[3] + b1[3]);
        *(LAS u32x4*)(lds + row * NSTR + ch * 16) = pk;
    }
    __syncthreads();
    const bf16_t* W = (const bf16_t*)(p.ws + WS_BWS) + (size_t)(j * 6 + g) * 128 * 128 + (16 * wid + fr) * 128 + 4 * fq;
    f32x4 acc[8];
#pragma unroll
    for (int d = 0; d < 8; ++d) acc[d] = (f32x4){0.f, 0.f, 0.f, 0.f};
    LAS unsigned char* vb = lds + (4 * fq + (fr >> 2)) * NSTR + (fr & 3) * 8;
    const int nks = (wid >> 1) + 1;
    for (int ks = 0; ks < nks; ++ks) {
        const u32x2 w0 = *(const u32x2*)(W + 32 * ks), w1 = *(const u32x2*)(W + 32 * ks + 16);
        u32x4 wp; wp[0] = w0[0]; wp[1] = w0[1]; wp[2] = w1[0]; wp[3] = w1[1];
        const bf16x8 wf = __builtin_bit_cast(bf16x8, wp);
#pragma unroll
        for (int d = 0; d < 8; ++d) {
            const s16x4 v1 = tr_read(vb + (32 * ks) * NSTR + d * 32), v2 = tr_read(vb + (32 * ks + 16) * NSTR + d * 32);
            const bf16x8 vf = __builtin_shufflevector(v1, v2, 0, 1, 2, 3, 4, 5, 6, 7);
            acc[d] = __builtin_amdgcn_mfma_f32_16x16x32_bf16(vf, wf, acc[d], 0, 0, 0);
        }
    }
    const int t = 16 * wid + fr;
    const float bias = p.in[11][(j * 6 + g) * 128 + t];
    const bf16_t* up = proj + (tok0 + t) * B_IN + 128 * g + 4 * fq;
    bf16_t* op = (bf16_t*)(p.ws + WS_MIX) + (tok0 + t) * 1024 + 128 * g + 4 * fq;
#pragma unroll
    for (int d = 0; d < 8; ++d) {
        const u32x2 ur = *(const u32x2*)(up + 16 * d);
        const float u0 = __uint_as_float(ur[0] << 16), u1 = __uint_as_float(ur[0] & 0xffff0000u), u2 = __uint_as_float(ur[1] << 16), u3 = __uint_as_float(ur[1] & 0xffff0000u);
        u32x2 pk; pk[0] = cvt_pk_bf16(u0 * (acc[d][0] + bias), u1 * (acc[d][1] + bias)); pk[1] = cvt_pk_bf16(u2 * (acc[d][2] + bias), u3 * (acc[d][3] + bias));
        *(u32x2*)(op + 16 * d) = pk;
    }
}

__device__ void mix_phase_b(const Params& p, LAS unsigned char* lds, int layer) {
    int tid = threadIdx.x; asm volatile("" : "+v"(tid));
    const int j = layer >> 1;
    const bf16_t* proj = (const bf16_t*)(p.ws + WS_BIG);
    for (int item = blockIdx.x; item < 512 * 10; item += gridDim.x) {
        const int sel = item % 10, cb = item / 10;
        if (sel < 6) gate_item(tid, p, lds, j, proj, cb, sel);
        else mem_item(tid, p, lds, layer, proj, B_IN, 1536, cb, sel - 6);
    }
}

__device__ void final_phase(const Params& p) {
    int tid = threadIdx.x; asm volatile("" : "+v"(tid));
    const int gw = (blockIdx.x * 512 + tid) >> 6, nw = (gridDim.x * 512) >> 6, lane = tid & 63;
    const unsigned long long* ss = (const unsigned long long*)(p.ws + WS_SS) + 8 * 65536; const float* g = p.in[5];
    f32x4 gg[4];
#pragma unroll
    for (int i = 0; i < 4; ++i) gg[i] = *(const f32x4*)(g + i * 256 + lane * 4);
    for (int row = gw; row < T_TOK; row += nw) {
        const float rs = rsqrtf((float)ss[row] * SS_INV + EPS);
        float* o = p.out + (size_t)row * 1024 + lane * 4;
#pragma unroll
        for (int i = 0; i < 4; ++i) { const f32x4 v = *(const f32x4*)(o + i * 256); *(f32x4*)(o + i * 256) = v * rs * gg[i]; }
    }
}

__device__ __forceinline__ void run_phase(const Params& p, LAS unsigned char* lds, int ph) {
    unsigned char* ws = p.ws;
    unsigned long long* ss = (unsigned long long*)(ws + WS_SS);
    bf16_t* h16 = (bf16_t*)(ws + WS_H16);
    bf16_t* big = (bf16_t*)(ws + WS_BIG);
    bf16_t* mix = (bf16_t*)(ws + WS_MIX);
    if (ph == 0) { prologue(p, lds); return; }
    if (ph == 1) { EpiProj<2> E; E.O = (bf16_t*)(ws + WS_MEMKV); E.ldc = 2048; E.ss = nullptr;
        run_gemm(lds, (const bf16_t*)(ws + WS_MEMN), (const bf16_t*)(ws + WS_WMKV), 2048, 2048, 1024, E); return; }
    if (ph == NPH - 1) { final_phase(p); return; }
    const int layer = (ph - 2) / 5, sub = (ph - 2) % 5, j = layer >> 1; const bool isB = layer & 1;
    if (sub == 0) {
        if (!isB) { EpiProj<0> E; E.O = big; E.ldc = A_IN; E.ss = ss + (2 * layer) * 65536;
            run_gemm(lds, h16, (const bf16_t*)(ws + WS_WAIN) + (size_t)j * A_IN * 1024, T_TOK, A_IN, 1024, E); }
        else { EpiProj<1> E; E.O = big; E.ldc = B_IN; E.ss = ss + (2 * layer) * 65536;
            run_gemm(lds, h16, (const bf16_t*)(ws + WS_WBIN) + (size_t)j * B_IN * 1024, T_TOK, B_IN, 1024, E); }
    } else if (sub == 1) {
        if (!isB) mix_phase_a(p, lds, layer); else mix_phase_b(p, lds, layer);
    } else if (sub == 2) {
        EpiRes E; E.hin = (layer == 0) ? p.in[0] : p.out; E.hout = p.out; E.h16 = h16; E.ssout = ss + (2 * layer + 1) * 65536;
        run_gemm(lds, mix, (const bf16_t*)(ws + (isB ? WS_WBOUT : WS_WAOUT)) + (size_t)j * 1024 * 1024, T_TOK, 1024, 1024, E);
    } else if (sub == 3) {
        EpiGateUp E; E.O = big; E.ss = ss + (2 * layer + 1) * 65536;
        run_gemm(lds, h16, (const bf16_t*)(ws + WS_WGU) + (size_t)layer * GU_N * 1024, T_TOK, GU_N, 1024, E);
    } else {
        EpiRes E; E.hin = p.out; E.hout = p.out; E.h16 = h16; E.ssout = ss + (2 * layer + 2) * 65536;
        run_gemm(lds, big, (const bf16_t*)(ws + WS_WDN) + (size_t)layer * 1024 * DFF, T_TOK, 1024, DFF, E);
    }
}

__global__ void __launch_bounds__(512, 2) mega(Params p) {
    extern __shared__ __attribute__((aligned(16))) unsigned char shm[];
    LAS unsigned char* lds = (LAS unsigned char*)shm;
#pragma unroll
    for (int ph = 0; ph < NPH; ++ph) {
        if (ph >= p.ph_lo && ph < p.ph_hi) {
            if (ph > p.ph_lo) cg::this_grid().sync();
            run_phase(p, lds, ph);
        }
    }
}

#ifndef MK_SPLIT
#define MK_SPLIT 0
#endif
extern "C" void kernel_launch(void* const* d_in, const int* in_sizes, int n_in, void* d_out, int out_size, void* d_ws, size_t ws_size, hipStream_t stream) {
    static int grid = 0;
    if (grid == 0) {
        int dev = 0, cus = 0, per_cu = 0;
        hipGetDevice(&dev);
        hipDeviceGetAttribute(&cus, hipDeviceAttributeMultiprocessorCount, dev);
        if (hipFuncSetAttribute((const void*)mega, hipFuncAttributeMaxDynamicSharedMemorySize, LDS_BYTES) != hipSuccess) fprintf(stderr, "kernel_launch: hipFuncSetAttribute failed\n");
        if (hipOccupancyMaxActiveBlocksPerMultiprocessor(&per_cu, (const void*)mega, 512, LDS_BYTES) != hipSuccess || per_cu < 1) { fprintf(stderr, "kernel_launch: occupancy query says %d\n", per_cu); per_cu = 1; }
        (void)hipGetLastError();
        grid = cus * per_cu;
        if (ws_size < WS_END) fprintf(stderr, "kernel_launch: workspace too small: %zu < %zu\n", ws_size, (size_t)WS_END);
    }
    Params p{};
    for (int i = 0; i < 18; ++i) p.in[i] = (const float*)d_in[i];
    p.out = (float*)d_out; p.ws = (unsigned char*)d_ws;
#if MK_SPLIT
    for (int ph = 0; ph < NPH; ++ph) { p.ph_lo = ph; p.ph_hi = ph + 1; hipLaunchKernelGGL(mega, dim3(grid), dim3(512), LDS_BYTES, stream, p); }
#else
    p.ph_lo = 0; p.ph_hi = NPH;
    void* args[] = {&p};
    hipError_t e = hipLaunchCooperativeKernel((const void*)mega, dim3(grid), dim3(512), args, LDS_BYTES, stream);
    if (e != hipSuccess) fprintf(stderr, "cooperative launch failed: %s (grid %d)\n", hipGetErrorString(e), grid);
#endif
}
```

```cpp
#include <hip/hip_runtime.h>
#include <hip/hip_cooperative_groups.h>
#include <cstdio>
namespace cg = cooperative_groups;
namespace pg8 {
#define PG8_LAS __attribute__((address_space(3)))
typedef unsigned short bf16_t;
typedef short bf16x8 __attribute__((ext_vector_type(8)));
typedef float f32x4 __attribute__((ext_vector_type(4)));
typedef unsigned u32x4 __attribute__((ext_vector_type(4)));
constexpr int BM = 256, BK = 64, HALF = 128, HTB = HALF * BK * 2  , STAGE_BYTES = 8 * HTB, NXCD = 8, WGM = 4;

__host__ __device__ __forceinline__ int lds_byte(int r, int c) { const int st = (r >> 4) * 2 + (c >> 5), rr = r & 15, cc = c & 31, ob = rr * 64 + cc * 2; return st * 1024 + (ob ^ (((ob >> 9) & 1) << 5)); }
__host__ __device__ __forceinline__ void stage_rc(int b, int& R, int& C) { const int st = b / 1024, sb = b % 1024, swz = sb ^ (((sb >> 9) & 1) << 5); R = (st >> 1) * 16 + swz / 64; C = (st & 1) * 32 + (swz % 64) / 2; }
__host__ __device__ __forceinline__ int perm32(int rho) { const int n = rho >> 4, i = rho & 15; return 8 * (i >> 2) + 4 * n + (i & 3); }
struct Unit { int pm, pn; };
struct Gemm { const bf16_t* A; const bf16_t* Bt; int M, N, K; };
struct StaticOrder {
    int nM, nN, nwg, G, c;
    __host__ __device__ void init(int M, int N, int G_, int c_) { nM = M / BM; nN = N / BM; nwg = nM * nN; G = G_; c = c_; }
    __host__ __device__ bool next(int i, Unit& u) const {
        const long L = (long)i * G + c; if (L >= nwg) return false;
        int wgid = (int)L; { const int q = nwg / NXCD, r = nwg % NXCD, xcd = wgid % NXCD, off = wgid / NXCD; wgid = (xcd < r ? xcd * (q + 1) : r * (q + 1) + (xcd - r) * q) + off; }
        const int nig = WGM * nN, gid = wgid / nig, fm = gid * WGM, gsz = (nM - fm) < WGM ? (nM - fm) : WGM;
        u.pm = fm + ((wgid % nig) % gsz); u.pn = (wgid % nig) / gsz; return true;
    }
    __device__ __forceinline__ void a_ready(const Unit&) const {}
    __device__ __forceinline__ void done(const Unit&) const {}
};
typedef float f32x2_t __attribute__((ext_vector_type(2)));
typedef __bf16 bf16x2_t __attribute__((ext_vector_type(2)));
__device__ __forceinline__ unsigned cvt_pk_bf16(float lo, float hi) { const f32x2_t v = {lo, hi}; const bf16x2_t b = __builtin_convertvector(v, bf16x2_t); return __builtin_bit_cast(unsigned, b); }
template <class Epi, class Sched, bool STAMP = false>
__device__ __forceinline__ void gemm_phase(PG8_LAS unsigned char* lds, const Gemm g, const Sched& S, const Epi& E, unsigned* stamps) {
    int tid_ = threadIdx.x; asm volatile("" : "+v"(tid_));
    const int tid = tid_, wid = __builtin_amdgcn_readfirstlane(tid >> 6), lane = tid & 63, wr = wid >> 2, wc = wid & 3, fr = lane & 15, fq = lane >> 4;
    const int K = g.K, nt = K / BK;
    int ts_lo = 0, ts_hi = 0, nts = 0; const unsigned rt_entry = STAMP ? (unsigned)wall_clock64() : 0ull;
#define PG8_STAMP() do { if (STAMP && wid == 0 && nts < 64) { const unsigned _c = (unsigned)clock64(); \
        ts_lo = (lane == nts) ? (int)(unsigned)_c : ts_lo; ts_hi = (lane == nts) ? (int)(unsigned)(_c >> 32) : ts_hi; ++nts; } } while (0)
    PG8_STAMP();
    unsigned voffA[2], voffB[2];
#pragma unroll
    for (int i = 0; i < 2; ++i) { int R, C; stage_rc(tid * 16 + i * 8192, R, C); const int Rb = Epi::PERM ? ((R & ~31) + perm32(R & 31)) : R;
        voffA[i] = (unsigned)(R * K + C) * 2u; voffB[i] = (unsigned)(Rb * K + C) * 2u; }
    const size_t kstep = (size_t)(BK * 2);
    const size_t hstep = (size_t)HALF * K * 2;
    const size_t tstep = 2 * hstep;
    const unsigned ldsw = (unsigned)wid * 1024u;
    const int aoff = lds_byte(wr * 64 + fr, fq * 8), boff = lds_byte(wc * 32 + fr, fq * 8);
#define PG8_SA(b, h) (((b) * 2 + (h)) * HTB)
#define PG8_SB(b, h) ((4 + (b) * 2 + (h)) * HTB)
#define PG8_STAGE(bufoff, gbase, voff) do { _Pragma("unroll") for (int _i = 0; _i < 2; ++_i) \
        __builtin_amdgcn_global_load_lds((const unsigned*)((const char*)(gbase) + (voff)[_i]), (PG8_LAS unsigned*)(lds + (bufoff) + ldsw + _i * 8192), 16, 0, 0); } while (0)
#define PG8_LDA(dst, b, h) do { _Pragma("unroll") for (int m = 0; m < 4; ++m) _Pragma("unroll") for (int k = 0; k < 2; ++k) dst[m][k] = *(const PG8_LAS bf16x8*)(lds + PG8_SA(b, h) + aoff + m * 2048 + k * 1024); } while (0)
#define PG8_LDB(dst, b, h) do { _Pragma("unroll") for (int n = 0; n < 2; ++n) _Pragma("unroll") for (int k = 0; k < 2; ++k) dst[n][k] = *(const PG8_LAS bf16x8*)(lds + PG8_SB(b, h) + boff + n * 2048 + k * 1024); } while (0)
#define PG8_MMA(ai, bj, At, Bt) do { __builtin_amdgcn_s_setprio(1); _Pragma("unroll") for (int m = 0; m < 4; ++m) _Pragma("unroll") for (int n = 0; n < 2; ++n) _Pragma("unroll") for (int k = 0; k < 2; ++k) \
        acc[ai][bj][m][n] = __builtin_amdgcn_mfma_f32_16x16x32_bf16(Bt[n][k], At[m][k], acc[ai][bj][m][n], 0, 0, 0); __builtin_amdgcn_s_setprio(0); } while (0)
#define PG8_WAIT_V(n) asm volatile("s_waitcnt vmcnt(" #n ")" ::: "memory")
#define PG8_WAIT_L(n) asm volatile("s_waitcnt lgkmcnt(" #n ")" ::: "memory")
#define PG8_BAR __builtin_amdgcn_s_barrier()
#define PG8_SCHED __builtin_amdgcn_sched_barrier(0)
    Unit cur, nxt; int ui = 0;
    if (!S.next(0, cur)) return;
    f32x4 acc[2][2][4][2];
#pragma unroll
    for (int a = 0; a < 2; ++a)
#pragma unroll
        for (int b = 0; b < 2; ++b)
#pragma unroll
            for (int m = 0; m < 4; ++m)
#pragma unroll
                for (int n = 0; n < 2; ++n) acc[a][b][m][n] = (f32x4){0.f, 0.f, 0.f, 0.f};
    bf16x8 At[4][2], B0[2][2], B1[2][2];
    const char* cA = (const char*)g.A + (size_t)cur.pm * tstep; const char* cB = (const char*)g.Bt + (size_t)cur.pn * tstep;
    S.a_ready(cur);
    PG8_STAGE(PG8_SB(0, 0), cB, voffB); PG8_STAGE(PG8_SA(0, 0), cA, voffA); PG8_STAGE(PG8_SB(0, 1), cB + hstep, voffB); PG8_STAGE(PG8_SA(0, 1), cA + hstep, voffA);
    if (wr == 1) PG8_BAR;
    PG8_WAIT_V(4); PG8_BAR;
    PG8_STAGE(PG8_SB(1, 0), cB + kstep, voffB); PG8_STAGE(PG8_SA(1, 0), cA + kstep, voffA); PG8_STAGE(PG8_SB(1, 1), cB + hstep + kstep, voffB);
    PG8_WAIT_V(6); PG8_BAR;
    PG8_STAMP();
    unsigned pre[8];
    for (;;) {
        E.pre(cur, wr, fr, pre);
        const bool has_next = S.next(ui + 1, nxt);
        const char* nA = has_next ? (const char*)g.A + (size_t)nxt.pm * tstep : cA; const char* nB = has_next ? (const char*)g.Bt + (size_t)nxt.pn * tstep : cB;
        for (int t = 0; t < nt; t += 2) {
            const bool last = (t == nt - 2);
            const char* a1 = cA + (size_t)(t + 1) * kstep;
            const char* a2 = last ? nA : cA + (size_t)(t + 2) * kstep; const char* b2 = last ? nB : cB + (size_t)(t + 2) * kstep;
            const char* a3 = a2 + kstep; const char* b3 = b2 + kstep;
            if (last && has_next) S.a_ready(nxt);
            PG8_LDB(B0, 0, 0); PG8_SCHED; PG8_LDA(At, 0, 0); PG8_STAGE(PG8_SA(1, 1), a1 + hstep, voffA);
            PG8_WAIT_L(8); PG8_BAR; PG8_WAIT_L(0); PG8_MMA(0, 0, At, B0); PG8_BAR; PG8_SCHED;
            PG8_LDB(B1, 0, 1); PG8_STAGE(PG8_SB(0, 0), b2, voffB);
            PG8_BAR; PG8_WAIT_L(0); PG8_MMA(0, 1, At, B1); PG8_BAR;
            PG8_LDA(At, 0, 1); PG8_STAGE(PG8_SA(0, 0), a2, voffA);
            PG8_BAR; PG8_WAIT_L(0); PG8_MMA(1, 0, At, B0); PG8_BAR; PG8_SCHED;
            PG8_STAGE(PG8_SB(0, 1), b2 + hstep, voffB);
            PG8_WAIT_V(6); PG8_BAR; PG8_MMA(1, 1, At, B1); PG8_BAR;
            PG8_LDB(B0, 1, 0); PG8_SCHED; PG8_LDA(At, 1, 0); PG8_STAGE(PG8_SA(0, 1), a2 + hstep, voffA);
            PG8_WAIT_L(8); PG8_BAR; PG8_WAIT_L(0); PG8_MMA(0, 0, At, B0); PG8_BAR; PG8_SCHED;
            PG8_LDB(B1, 1, 1); PG8_STAGE(PG8_SB(1, 0), b3, voffB);
            PG8_BAR; PG8_WAIT_L(0); PG8_MMA(0, 1, At, B1); PG8_BAR;
            PG8_LDA(At, 1, 1); PG8_STAGE(PG8_SA(1, 0), a3, voffA);
            PG8_BAR; PG8_WAIT_L(0); PG8_MMA(1, 0, At, B0); PG8_BAR; PG8_SCHED;
            PG8_STAGE(PG8_SB(1, 1), b3 + hstep, voffB);
            PG8_WAIT_V(6); PG8_BAR; PG8_MMA(1, 1, At, B1); PG8_BAR;
        }
        PG8_STAMP();
        if constexpr (!Epi::AFTER_DRAIN) { E(acc, cur, wr, wc, fr, fq, pre); S.done(cur); }
        PG8_STAMP();
        if (!has_next) break;
#pragma unroll
        for (int a = 0; a < 2; ++a)
#pragma unroll
            for (int b = 0; b < 2; ++b)
#pragma unroll
                for (int m = 0; m < 4; ++m)
#pragma unroll
                    for (int n = 0; n < 2; ++n) acc[a][b][m][n] = (f32x4){0.f, 0.f, 0.f, 0.f};
        cur = nxt; cA = nA; cB = nB; ++ui;
    }
    PG8_WAIT_V(0);
    if (wr == 0) PG8_BAR;
    PG8_BAR;
    if constexpr (Epi::AFTER_DRAIN) { E.fused(acc, cur, wr, wc, fr, fq, lds, wid, lane); S.done(cur); }
    PG8_STAMP();
    if (STAMP && wid == 0) { stamps[lane] = lane < nts ? (((unsigned)(unsigned)ts_hi << 32) | (unsigned)ts_lo) : 0ull;
        if (lane == 62) stamps[62] = rt_entry; if (lane == 63) stamps[63] = (unsigned)wall_clock64(); }
#undef PG8_STAMP
#undef PG8_SA
#undef PG8_SB
#undef PG8_STAGE
#undef PG8_LDA
#undef PG8_LDB
#undef PG8_MMA
#undef PG8_WAIT_V
#undef PG8_WAIT_L
#undef PG8_BAR
#undef PG8_SCHED
}
}

using pg8::bf16_t; using pg8::bf16x8; using pg8::f32x4; using pg8::u32x4; using pg8::Unit; using pg8::cvt_pk_bf16;
#define LAS PG8_LAS
typedef short s16x4 __attribute__((ext_vector_type(4)));
typedef unsigned u32x2 __attribute__((ext_vector_type(2)));

constexpr int T_TOK = 65536, SEQ = 8192;
constexpr int A_IN = 1280, B_IN = 1792, DFF = 2816, GU_N = 5632;
constexpr float EPS = 1e-6f;
constexpr float SS_SCALE = 64.f, SS_INV = 1.f / (64.f * 1024.f);
constexpr int LDS_STAGE = 131072, LDS_BYTES = LDS_STAGE + 16;
constexpr int NPH = 23;
#ifndef PROBE_MIX
#define PROBE_MIX 1
#endif
#ifndef PROBE_X
#define PROBE_X 1
#endif
#ifndef PROBE_P0
#define PROBE_P0 1
#endif

constexpr size_t WS_WAIN  = 0;
constexpr size_t WS_WBIN  = WS_WAIN  + 2ull * 1280 * 1024 * 2;
constexpr size_t WS_WAOUT = WS_WBIN  + 2ull * 1792 * 1024 * 2;
constexpr size_t WS_WBOUT = WS_WAOUT + 2ull * 1024 * 1024 * 2;
constexpr size_t WS_WMKV  = WS_WBOUT + 2ull * 1024 * 1024 * 2;
constexpr size_t WS_WGU   = WS_WMKV  + 2048ull * 1024 * 2;
constexpr size_t WS_WDN   = WS_WGU   + 4ull * 5632 * 1024 * 2;
constexpr size_t WS_BWS   = WS_WDN   + 4ull * 1024 * 2816 * 2;
constexpr size_t WS_MEMN  = WS_BWS   + 2ull * 6 * 128 * 128 * 2;
constexpr size_t WS_MEMKV = WS_MEMN  + 2048ull * 1024 * 2;
constexpr size_t WS_SS    = WS_MEMKV + 2048ull * 2048 * 2;
constexpr size_t WS_H16   = WS_SS    + 9ull * 65536 * 4;
constexpr size_t WS_BIG   = WS_H16   + 65536ull * 1024 * 2;
constexpr size_t WS_MIX   = WS_BIG   + 65536ull * 1792 * 2;
constexpr size_t WS_END   = WS_BIG   + 65536ull * 2816 * 2;
constexpr size_t WS_BAR   = WS_END;
constexpr size_t WS_TOTAL = WS_BAR + 3456 * 4;

#define XB_TMO      128
#define XB_XCNT(j)  (256  + 64 * (j))
#define XB_XSUB(j)  (1280 + 64 * (j))
#define XB_XGEN(j)  (2304 + 64 * (j))
#define XB_TOP      3328
#define XB_TOPGEN   3392
#define XCD_BAR_WORDS 3456
#define XB_SPIN_CAP (1u << 18)

__device__ __forceinline__ unsigned xb_ld(unsigned* p)              { return __hip_atomic_load(p, __ATOMIC_RELAXED, __HIP_MEMORY_SCOPE_AGENT); }
__device__ __forceinline__ unsigned xb_add(unsigned* p, unsigned v) { return __hip_atomic_fetch_add(p, v, __ATOMIC_RELAXED, __HIP_MEMORY_SCOPE_AGENT); }
__device__ __forceinline__ unsigned xb_xcc_id() { return (unsigned)__builtin_amdgcn_s_getreg((3 << 11) | 20) & 0xFu; }
#define XB_SPIN(cond, bar) do { unsigned _sp = 0; while (cond) { __builtin_amdgcn_s_sleep(0); \
    if ((++_sp & 255u) == 0u) { if (xb_ld(&(bar)[XB_TMO])) break; if (_sp > XB_SPIN_CAP) { atomicAdd(&(bar)[XB_TMO], 1u); break; } } } } while (0)

struct XcdBarrier {
    unsigned* bar; unsigned x;
    volatile LAS unsigned* st;
};

__device__ __forceinline__ XcdBarrier xcd_barrier_post(unsigned* bar, volatile LAS unsigned* st) {
    XcdBarrier b; b.bar = bar; b.x = xb_xcc_id(); b.st = st;
    if (threadIdx.x == 0) (void)xb_add(&bar[XB_XCNT(b.x)], 1u);
    return b;
}
__device__ __forceinline__ void xcd_barrier_complete(unsigned* bar, unsigned x, unsigned& nloc, unsigned& nx) {
    const unsigned G = gridDim.x * gridDim.y * gridDim.z;
    unsigned sum, cnt, mine, sp = 0u;
    for (;;) {
        sum = 0u; cnt = 0u; mine = 0u;
#pragma unroll
        for (unsigned j = 0; j < 16; ++j) { const unsigned c = xb_ld(&bar[XB_XCNT(j)]); sum += c; cnt += (c > 0u) ? 1u : 0u; mine = (j == x) ? c : mine; }
        if (sum == G) break;
        __builtin_amdgcn_s_sleep(1);
        if ((++sp & 255u) == 0u) { if (xb_ld(&bar[XB_TMO])) break; if (sp > XB_SPIN_CAP) { atomicAdd(&bar[XB_TMO], 1u); break; } }
    }
    nloc = mine > 0u ? mine : 1u; nx = cnt > 0u ? cnt : 1u;
}

__device__ __forceinline__ void xcd_barrier(const XcdBarrier& b) {
    asm volatile("s_waitcnt vmcnt(0)" ::: "memory");
    __syncthreads();
    if (threadIdx.x == 0) {
        unsigned* bar = b.bar;
        __builtin_amdgcn_s_waitcnt(0);
        unsigned nloc = b.st[0], nx = b.st[1];
        if (nloc == 0u) { xcd_barrier_complete(bar, b.x, nloc, nx); b.st[0] = nloc; b.st[1] = nx; }
        const unsigned old = xb_add(&bar[XB_XSUB(b.x)], 1u);
        const unsigned gen = old / nloc;
        if (old + 1u == (gen + 1u) * nloc) {
            __builtin_amdgcn_fence(__ATOMIC_RELEASE, "agent");
            asm volatile("s_waitcnt vmcnt(0)" ::: "memory");
            const unsigned og = xb_add(&bar[XB_TOP], 1u);
            const unsigned tg = og / nx;
            if (og + 1u == (tg + 1u) * nx) xb_add(&bar[XB_TOPGEN], 1u);
            else XB_SPIN(xb_ld(&bar[XB_TOPGEN]) == tg, bar);
            __builtin_amdgcn_fence(__ATOMIC_ACQUIRE, "agent");
            xb_add(&bar[XB_XGEN(b.x)], 1u);
            asm volatile("s_waitcnt vmcnt(0)" ::: "memory");
        } else {
            XB_SPIN(xb_ld(&bar[XB_XGEN(b.x)]) == gen, bar);
            __builtin_amdgcn_fence(__ATOMIC_ACQUIRE, "agent");
            asm volatile("s_waitcnt vmcnt(0)" ::: "memory");
        }
    }
    __syncthreads();
}


struct Params { const float* in[18]; float* out; unsigned char* ws; int ph_lo, ph_hi; };

__device__ __forceinline__ float bf2f(unsigned short b) { return __uint_as_float(((unsigned)b) << 16); }
__device__ __forceinline__ float wave_sum(float v) {
#pragma unroll
    for (int o = 32; o; o >>= 1) v += __shfl_xor(v, o);
    return v;
}
__device__ __forceinline__ float row16_sum(float v) {
    v += __int_as_float(__builtin_amdgcn_update_dpp(0, __float_as_int(v), 0xB1, 0xF, 0xF, false));
    v += __int_as_float(__builtin_amdgcn_update_dpp(0, __float_as_int(v), 0x4E, 0xF, 0xF, false));
    v += __int_as_float(__builtin_amdgcn_update_dpp(0, __float_as_int(v), 0x124, 0xF, 0xF, false));
    v += __int_as_float(__builtin_amdgcn_update_dpp(0, __float_as_int(v), 0x128, 0xF, 0xF, false));
    return v;
}
__device__ __forceinline__ float xrow_sum(float x) {
    const auto a = __builtin_amdgcn_permlane16_swap(__float_as_uint(x), __float_as_uint(x), false, false);
    x = __uint_as_float(a[0]) + __uint_as_float(a[1]);
    const auto b = __builtin_amdgcn_permlane32_swap(__float_as_uint(x), __float_as_uint(x), false, false);
    return __uint_as_float(b[0]) + __uint_as_float(b[1]);
}
__device__ __forceinline__ float xrow_max(float x) {
    const auto a = __builtin_amdgcn_permlane16_swap(__float_as_uint(x), __float_as_uint(x), false, false);
    x = fmaxf(__uint_as_float(a[0]), __uint_as_float(a[1]));
    const auto b = __builtin_amdgcn_permlane32_swap(__float_as_uint(x), __float_as_uint(x), false, false);
    return fmaxf(__uint_as_float(b[0]), __uint_as_float(b[1]));
}
__device__ __forceinline__ float gelu_t(float x) {
    const float u = 0.7978845608028654f * x * (1.f + 0.044715f * x * x);
    const float e = __builtin_amdgcn_exp2f(-2.885390081777927f * u);
    return x * __builtin_amdgcn_rcpf(1.f + e);
}

template <int MODE> struct EpiProj {
    static constexpr bool PERM = true, AFTER_DRAIN = false;
    bf16_t* O; int ldc; const unsigned* ss;
    __device__ __forceinline__ void pre(const Unit& u, int wr, int fr, unsigned (&pr)[8]) const {
        if (MODE != 2) {
#pragma unroll
            for (int i = 0; i < 8; ++i) pr[i] = ss[u.pm * 256 + wr * 64 + fr + (i >> 2) * 128 + (i & 3) * 16];
        }
    }
    __device__ __forceinline__ void operator()(const f32x4 (&acc)[2][2][4][2], const Unit& u, int wr, int wc, int fr, int fq, const unsigned (&pr)[8]) const {
        const int row0 = u.pm * 256 + wr * 64 + fr, col0 = u.pn * 256 + wc * 32 + 8 * fq;
        const bool act = (MODE == 1) && (u.pn < 6);
#pragma unroll
        for (int ai = 0; ai < 2; ++ai)
#pragma unroll
            for (int m = 0; m < 4; ++m) {
                const int row = row0 + ai * 128 + m * 16;
                float rs = 1.f; if (MODE != 2) rs = rsqrtf((float)pr[ai * 4 + m] * SS_INV + EPS);
#pragma unroll
                for (int bj = 0; bj < 2; ++bj) {
                    f32x4 v0 = acc[ai][bj][m][0] * rs, v1 = acc[ai][bj][m][1] * rs;
                    if (act) {
#pragma unroll
                        for (int e = 0; e < 4; ++e) { v0[e] = gelu_t(v0[e]); v1[e] = gelu_t(v1[e]); }
                    }
                    u32x4 pk; pk[0] = cvt_pk_bf16(v0[0], v0[1]); pk[1] = cvt_pk_bf16(v0[2], v0[3]); pk[2] = cvt_pk_bf16(v1[0], v1[1]); pk[3] = cvt_pk_bf16(v1[2], v1[3]);
                    const int c = col0 + bj * 128;
                    bf16_t* dstp;
                    if (MODE == 0) dstp = O + (size_t)(c >> 6) * ((size_t)T_TOK * 64) + (size_t)row * 64 + (c & 63);
                    else if (MODE == 1) dstp = (c < 1536) ? O + (size_t)(c >> 7) * ((size_t)T_TOK * 128) + (size_t)row * 128 + (c & 127)
                                                          : O + (size_t)12 * T_TOK * 128 + (size_t)((c - 1536) >> 6) * ((size_t)T_TOK * 64) + (size_t)row * 64 + (c & 63);
                    else dstp = O + (size_t)row * ldc + c;
                    *(u32x4*)dstp = pk;
                }
            }
    }
};
struct EpiGateUp {
    static constexpr bool PERM = true, AFTER_DRAIN = false;
    bf16_t* O; const unsigned* ss;
    __device__ __forceinline__ void pre(const Unit& u, int wr, int fr, unsigned (&pr)[8]) const {
#pragma unroll
        for (int i = 0; i < 8; ++i) pr[i] = ss[u.pm * 256 + wr * 64 + fr + (i >> 2) * 128 + (i & 3) * 16];
    }
    __device__ __forceinline__ void operator()(const f32x4 (&acc)[2][2][4][2], const Unit& u, int wr, int wc, int fr, int fq, const unsigned (&pr)[8]) const {
        const int row0 = u.pm * 256 + wr * 64 + fr, col0 = u.pn * 128 + wc * 32 + 8 * fq;
#pragma unroll
        for (int ai = 0; ai < 2; ++ai)
#pragma unroll
            for (int m = 0; m < 4; ++m) {
                const int row = row0 + ai * 128 + m * 16;
                const float rs = rsqrtf((float)pr[ai * 4 + m] * SS_INV + EPS);
                float o[8];
#pragma unroll
                for (int bj = 0; bj < 2; ++bj) {
                    const f32x4 g = acc[ai][bj][m][0] * rs, up = acc[ai][bj][m][1] * rs;
#pragma unroll
                    for (int e = 0; e < 4; ++e) o[4 * bj + e] = g[e] * up[e] * __builtin_amdgcn_rcpf(1.f + __builtin_amdgcn_exp2f(-1.4426950408889634f * g[e]));
                }
                u32x4 pk; pk[0] = cvt_pk_bf16(o[0], o[1]); pk[1] = cvt_pk_bf16(o[2], o[3]); pk[2] = cvt_pk_bf16(o[4], o[5]); pk[3] = cvt_pk_bf16(o[6], o[7]);
                *(u32x4*)(O + (size_t)row * DFF + col0) = pk;
            }
    }
};
template <int SRC, bool F32OUT> struct EpiRes {
    static constexpr bool PERM = true, AFTER_DRAIN = false;
    const float* x; float* hout; bf16_t* h16; unsigned* ssout;
    __device__ __forceinline__ void pre(const Unit&, int, int, unsigned (&)[8]) const {}
    __device__ __forceinline__ void row_out(const f32x4 (&acc)[2][2][4][2], int ai, int m, int row, int col0, f32x4 (&v)[2][2], int fq) const {
        bf16_t* bp = h16 + (size_t)row * 1024 + col0;
        float sq = 0.f;
#pragma unroll
        for (int bj = 0; bj < 2; ++bj) {
            const f32x4 v0 = v[bj][0] + acc[ai][bj][m][0], v1 = v[bj][1] + acc[ai][bj][m][1];
            if (F32OUT) { float* op = hout + (size_t)row * 1024 + col0 + bj * 128; *(f32x4*)op = v0; *(f32x4*)(op + 4) = v1; }
            else { u32x4 pk; pk[0] = cvt_pk_bf16(v0[0], v0[1]); pk[1] = cvt_pk_bf16(v0[2], v0[3]); pk[2] = cvt_pk_bf16(v1[0], v1[1]); pk[3] = cvt_pk_bf16(v1[2], v1[3]);
                *(u32x4*)(bp + bj * 128) = pk; }
            sq += v0[0] * v0[0] + v0[1] * v0[1] + v0[2] * v0[2] + v0[3] * v0[3] + v1[0] * v1[0] + v1[1] * v1[1] + v1[2] * v1[2] + v1[3] * v1[3];
        }
        sq = xrow_sum(sq);
        if (fq == 0) atomicAdd(ssout + row, (unsigned)(sq * SS_SCALE));
    }
    __device__ __forceinline__ void unpack(const u32x4 r, f32x4 (&v)[2]) const {
        v[0][0] = __uint_as_float(r[0] << 16); v[0][1] = __uint_as_float(r[0] & 0xffff0000u); v[0][2] = __uint_as_float(r[1] << 16); v[0][3] = __uint_as_float(r[1] & 0xffff0000u);
        v[1][0] = __uint_as_float(r[2] << 16); v[1][1] = __uint_as_float(r[2] & 0xffff0000u); v[1][2] = __uint_as_float(r[3] << 16); v[1][3] = __uint_as_float(r[3] & 0xffff0000u);
    }
    __device__ __forceinline__ void operator()(const f32x4 (&acc)[2][2][4][2], const Unit& u, int wr, int wc, int fr, int fq, const unsigned (&)[8]) const {
        const int row0 = u.pm * 256 + wr * 64 + fr, col0 = u.pn * 256 + wc * 32 + 8 * fq;
        if (SRC == 0) {
#pragma unroll
            for (int ai = 0; ai < 2; ++ai) {
                u32x4 ra[4][2];
#pragma unroll
                for (int m = 0; m < 4; ++m)
#pragma unroll
                    for (int bj = 0; bj < 2; ++bj) ra[m][bj] = *(const u32x4*)(h16 + (size_t)(row0 + ai * 128 + m * 16) * 1024 + col0 + bj * 128);
#pragma unroll
                for (int m = 0; m < 4; ++m) { f32x4 v[2][2]; unpack(ra[m][0], v[0]); unpack(ra[m][1], v[1]); row_out(acc, ai, m, row0 + ai * 128 + m * 16, col0, v, fq); }
            }
        } else {
#pragma unroll
            for (int ai = 0; ai < 2; ++ai) {
                f32x4 xf[4][2][2];
#pragma unroll
                for (int m = 0; m < 4; ++m)
#pragma unroll
                    for (int bj = 0; bj < 2; ++bj) { const float* ip = x + (size_t)(row0 + ai * 128 + m * 16) * 1024 + col0 + bj * 128; xf[m][bj][0] = *(const f32x4*)ip; xf[m][bj][1] = *(const f32x4*)(ip + 4); }
#pragma unroll
                for (int m = 0; m < 4; ++m) row_out(acc, ai, m, row0 + ai * 128 + m * 16, col0, xf[m], fq);
            }
        }
    }
};

template <class Epi> __device__ __forceinline__ void run_gemm(LAS unsigned char* lds, const bf16_t* A, const bf16_t* Bt, int M, int N, int K, const Epi& E) {
    pg8::Gemm g; g.A = A; g.Bt = Bt; g.M = M; g.N = N; g.K = K;
    pg8::StaticOrder S; S.init(M, N, (int)gridDim.x, (int)blockIdx.x);
    pg8::gemm_phase<Epi, pg8::StaticOrder, false>(lds, g, S, E, nullptr);
}

__device__ __forceinline__ void conv_tile(const int tid, LAS float* t, const float* src, bf16_t* dst, int K, int N, const float* gain, int mode, int tile) {
    const int ntn = N >> 6, tk = tile / ntn, tn = tile - tk * ntn, k0 = tk * 64, n0 = tn * 64;
    {
        const int kr = tid >> 3, nc = (tid & 7) * 8;
        const float* s = src + (size_t)(k0 + kr) * N + n0 + nc;
        const f32x4 a = *(const f32x4*)s, b = *(const f32x4*)(s + 4);
        const float gs = gain ? gain[k0 + kr] : 1.f;
        LAS float* tp = t + kr * 65 + nc;
        tp[0] = a[0] * gs; tp[1] = a[1] * gs; tp[2] = a[2] * gs; tp[3] = a[3] * gs; tp[4] = b[0] * gs; tp[5] = b[1] * gs; tp[6] = b[2] * gs; tp[7] = b[3] * gs;
    }
    __syncthreads();
    {
        const int nr = tid >> 3, kc = (tid & 7) * 8, n = n0 + nr;
        float cs = 1.f;
        if (mode == 1 && (n < 768 || n >= 1024)) cs = 0.125f;
        if (mode == 2 && n >= 1536) cs = 0.125f;
        int drow = n;
        if (mode == 3) { const int up = (n >= DFF) ? 1 : 0, j = n - DFF * up, r = j & 127; drow = 256 * (j >> 7) + 128 * ((r >> 2) & 1) + 32 * (r >> 5) + 8 * ((r >> 3) & 3) + 4 * up + (r & 3); }
        float v[8];
#pragma unroll
        for (int e = 0; e < 8; ++e) v[e] = t[(kc + e) * 65 + nr] * cs;
        u32x4 pk; pk[0] = cvt_pk_bf16(v[0], v[1]); pk[1] = cvt_pk_bf16(v[2], v[3]); pk[2] = cvt_pk_bf16(v[4], v[5]); pk[3] = cvt_pk_bf16(v[6], v[7]);
        *(u32x4*)(dst + (size_t)drow * K + k0 + kc) = pk;
    }
    __syncthreads();
}
__device__ __forceinline__ void conv_job(const int tid, LAS float* t, const float* src, bf16_t* dst, int K, int N, const float* gain, int mode) {
    const int nt = (K >> 6) * (N >> 6);
    for (int tile = blockIdx.x; tile < nt; tile += gridDim.x) conv_tile(tid, t, src, dst, K, N, gain, mode, tile);
}

__device__ void prologue(const Params& p, LAS unsigned char* lds) {
    LAS float* t = (LAS float*)lds;
    unsigned char* ws = p.ws;
    int tid = threadIdx.x; asm volatile("" : "+v"(tid));
    for (int j = 0; j < 2; ++j) {
        conv_job(tid, t, p.in[6] + (size_t)j * 1024 * A_IN, (bf16_t*)(ws + WS_WAIN) + (size_t)j * A_IN * 1024, 1024, A_IN, p.in[3] + (2 * j) * 1024, 1);
        conv_job(tid, t, p.in[9] + (size_t)j * 1024 * B_IN, (bf16_t*)(ws + WS_WBIN) + (size_t)j * B_IN * 1024, 1024, B_IN, p.in[3] + (2 * j + 1) * 1024, 2);
        conv_job(tid, t, p.in[8] + (size_t)j * 1024 * 1024, (bf16_t*)(ws + WS_WAOUT) + (size_t)j * 1024 * 1024, 1024, 1024, nullptr, 0);
        conv_job(tid, t, p.in[14] + (size_t)j * 1024 * 1024, (bf16_t*)(ws + WS_WBOUT) + (size_t)j * 1024 * 1024, 1024, 1024, nullptr, 0);
    }
    for (int i = 0; i < 4; ++i) {
        conv_job(tid, t, p.in[15] + (size_t)i * 1024 * 512, (bf16_t*)(ws + WS_WMKV) + (size_t)i * 512 * 1024, 1024, 512, nullptr, 0);
        conv_job(tid, t, p.in[16] + (size_t)i * 1024 * GU_N, (bf16_t*)(ws + WS_WGU) + (size_t)i * GU_N * 1024, 1024, GU_N, p.in[4] + i * 1024, 3);
        conv_job(tid, t, p.in[17] + (size_t)i * DFF * 1024, (bf16_t*)(ws + WS_WDN) + (size_t)i * 1024 * DFF, DFF, 1024, nullptr, 0);
    }
    const int gtid = blockIdx.x * 512 + tid, gn = gridDim.x * 512;
    { const float* s = p.in[10]; bf16_t* d = (bf16_t*)(ws + WS_BWS);
      for (int i = gtid; i < 2 * 6 * 128 * 128; i += gn) { const int tt = (i >> 7) & 127, sidx = i & 127; const float v = (sidx <= tt) ? s[i] : 0.f; d[i] = (bf16_t)(cvt_pk_bf16(v, 0.f) & 0xffffu); } }
    { unsigned* ss = (unsigned*)(ws + WS_SS) + 65536;
      for (int i = gtid; i < 8 * 65536; i += gn) ss[i] = 0u; }
    const int gw = gtid >> 6, nw = gn >> 6, lane = tid & 63;
    { const float* mem = p.in[1]; const float* g = p.in[2]; bf16_t* mn = (bf16_t*)(ws + WS_MEMN);
      for (int row = gw; row < 2048; row += nw) {
          f32x4 v[4]; float sq = 0.f;
#pragma unroll
          for (int i = 0; i < 4; ++i) { v[i] = *(const f32x4*)(mem + (size_t)row * 1024 + i * 256 + lane * 4); sq += v[i][0] * v[i][0] + v[i][1] * v[i][1] + v[i][2] * v[i][2] + v[i][3] * v[i][3]; }
          sq = wave_sum(sq); const float rs = rsqrtf(sq * (1.f / 1024.f) + EPS);
#pragma unroll
          for (int i = 0; i < 4; ++i) { const f32x4 gg = *(const f32x4*)(g + i * 256 + lane * 4); const f32x4 o = v[i] * rs * gg;
              u32x2 pk; pk[0] = cvt_pk_bf16(o[0], o[1]); pk[1] = cvt_pk_bf16(o[2], o[3]); *(u32x2*)(mn + (size_t)row * 1024 + i * 256 + lane * 4) = pk; }
      } }
    for (int rep = 0; rep < PROBE_X; ++rep)
    { const float* x = p.in[0]; bf16_t* h16 = (bf16_t*)(ws + WS_H16); unsigned* ss0 = (unsigned*)(ws + WS_SS);
      for (int row0 = gw * 4; row0 < T_TOK; row0 += nw * 4) {
          f32x4 v[4][4];
#pragma unroll
          for (int r = 0; r < 4; ++r)
#pragma unroll
              for (int i = 0; i < 4; ++i) v[r][i] = *(const f32x4*)(x + (size_t)(row0 + r) * 1024 + i * 256 + lane * 4);
          float sq[4];
#pragma unroll
          for (int r = 0; r < 4; ++r) { sq[r] = 0.f;
#pragma unroll
              for (int i = 0; i < 4; ++i) { const f32x4 w = v[r][i]; sq[r] += w[0] * w[0] + w[1] * w[1] + w[2] * w[2] + w[3] * w[3];
                  u32x2 pk; pk[0] = cvt_pk_bf16(w[0], w[1]); pk[1] = cvt_pk_bf16(w[2], w[3]); *(u32x2*)(h16 + (size_t)(row0 + r) * 1024 + i * 256 + lane * 4) = pk; } }
#pragma unroll
          for (int o = 32; o; o >>= 1) {
#pragma unroll
              for (int r = 0; r < 4; ++r) sq[r] += __shfl_xor(sq[r], o);
          }
          if (lane < 4) ss0[row0 + lane] = (unsigned)((lane == 0 ? sq[0] : lane == 1 ? sq[1] : lane == 2 ? sq[2] : sq[3]) * SS_SCALE);
      } }
}

constexpr int KSTR = 144, VSTR = 160, K_OFF = 0, V_OFF = 256 * KSTR;
__device__ __forceinline__ s16x4 tr_read(LAS unsigned char* a) { return __builtin_amdgcn_ds_read_tr16_b64_v4i16((LAS s16x4*)a); }

template <bool SWA> __device__ __forceinline__ void attn_item(const int tid, LAS unsigned char* lds, const bf16_t* Q, int ldq, const bf16_t* Kg, const bf16_t* Vg, int ldkv, bool zfirst, float sink, bf16_t* O) {
    const int wid = __builtin_amdgcn_readfirstlane(tid >> 6), lane = tid & 63, fr = lane & 15, fq = lane >> 4;
    __syncthreads();
#pragma unroll
    for (int i = 0; i < 4; ++i) {
        const int c = tid + 512 * i, row = c >> 3, ch = c & 7;
        u32x4 kv = (u32x4){0u, 0u, 0u, 0u}, vv = (u32x4){0u, 0u, 0u, 0u};
        if (!(zfirst && i < 2)) { kv = *(const u32x4*)(Kg + (long)row * ldkv + ch * 8); vv = *(const u32x4*)(Vg + (long)row * ldkv + ch * 8); }
        *(LAS u32x4*)(lds + K_OFF + row * KSTR + ch * 16) = kv;
        *(LAS u32x4*)(lds + V_OFF + row * VSTR + ch * 16) = vv;
    }
    const bf16_t* qp = Q + (long)(16 * wid + fr) * ldq + fq * 8;
    const bf16x8 q0 = *(const bf16x8*)qp, q1 = *(const bf16x8*)(qp + 32);
    __syncthreads();
    f32x4 s[16];
#pragma unroll
    for (int sub = 0; sub < 16; ++sub) {
        s[sub] = (f32x4){0.f, 0.f, 0.f, 0.f};
        const bf16x8 a0 = *(const LAS bf16x8*)(lds + K_OFF + (16 * sub + fr) * KSTR + fq * 16);
        const bf16x8 a1 = *(const LAS bf16x8*)(lds + K_OFF + (16 * sub + fr) * KSTR + 64 + fq * 16);
        s[sub] = __builtin_amdgcn_mfma_f32_16x16x32_bf16(a0, q0, s[sub], 0, 0, 0);
        s[sub] = __builtin_amdgcn_mfma_f32_16x16x32_bf16(a1, q1, s[sub], 0, 0, 0);
    }
    const int qi = 16 * wid + fr;
    float mx = SWA ? sink : -INFINITY;
#pragma unroll
    for (int sub = 0; sub < 16; ++sub)
#pragma unroll
        for (int j = 0; j < 4; ++j) {
            if (SWA) { const int kj = 16 * sub + 4 * fq + j; const bool ok = (kj > qi) && (kj <= qi + 128) && (!zfirst || kj >= 128); if (!ok) s[sub][j] = -INFINITY; }
            mx = fmaxf(mx, s[sub][j]);
        }
    mx = xrow_max(mx);
    float sum = 0.f;
#pragma unroll
    for (int sub = 0; sub < 16; ++sub)
#pragma unroll
        for (int j = 0; j < 4; ++j) { const float e = __builtin_amdgcn_exp2f((s[sub][j] - mx) * 1.4426950408889634f); s[sub][j] = e; sum += e; }
    sum = xrow_sum(sum);
    if (SWA) sum += __builtin_amdgcn_exp2f((sink - mx) * 1.4426950408889634f);
    const float inv = 1.f / sum;
    f32x4 o[4];
#pragma unroll
    for (int d = 0; d < 4; ++d) o[d] = (f32x4){0.f, 0.f, 0.f, 0.f};
    LAS unsigned char* vb = lds + V_OFF + (4 * fq + (fr >> 2)) * VSTR + (fr & 3) * 8;
#pragma unroll
    for (int kk = 0; kk < 8; ++kk) {
        const f32x4 p0 = s[2 * kk] * inv, p1 = s[2 * kk + 1] * inv;
        u32x4 pk; pk[0] = cvt_pk_bf16(p0[0], p0[1]); pk[1] = cvt_pk_bf16(p0[2], p0[3]); pk[2] = cvt_pk_bf16(p1[0], p1[1]); pk[3] = cvt_pk_bf16(p1[2], p1[3]);
        const bf16x8 pf = __builtin_bit_cast(bf16x8, pk);
#pragma unroll
        for (int d = 0; d < 4; ++d) {
            const s16x4 v1 = tr_read(vb + (32 * kk) * VSTR + d * 32), v2 = tr_read(vb + (32 * kk + 16) * VSTR + d * 32);
            const bf16x8 vf = __builtin_shufflevector(v1, v2, 0, 1, 2, 3, 4, 5, 6, 7);
            o[d] = __builtin_amdgcn_mfma_f32_16x16x32_bf16(vf, pf, o[d], 0, 0, 0);
        }
    }
    bf16_t* op = O + (long)(16 * wid + fr) * 1024 + 4 * fq;
#pragma unroll
    for (int d = 0; d < 4; ++d) { u32x2 pk; pk[0] = cvt_pk_bf16(o[d][0], o[d][1]); pk[1] = cvt_pk_bf16(o[d][2], o[d][3]); *(u32x2*)(op + 16 * d) = pk; }
}

__device__ __forceinline__ void mem_item(const int tid, const Params& p, LAS unsigned char* lds, int layer, const bf16_t* proj, int ldp, int qoff, int qb, int mh) {
    const int b = qb >> 6; const long tok0 = (long)qb * 128;
    const bf16_t* kv = (const bf16_t*)(p.ws + WS_MEMKV) + (long)b * 256 * 2048 + layer * 512 + mh * 64;
    attn_item<false>(tid, lds, proj + tok0 * ldp + qoff + mh * 64, ldp, kv, kv + 256, 2048, false, 0.f, (bf16_t*)(p.ws + WS_MIX) + tok0 * 1024 + 768 + mh * 64);
}

struct KV8 { u32x4 k[4], v[4]; };
__device__ __forceinline__ void kv_load(KV8& r, int tid, const bf16_t* Kg, const bf16_t* Vg, int ldkv, bool zfirst) {
#pragma unroll
    for (int i = 0; i < 4; ++i) {
        const int c = tid + 512 * i, row = c >> 3, ch = c & 7;
        r.k[i] = (u32x4){0u, 0u, 0u, 0u}; r.v[i] = (u32x4){0u, 0u, 0u, 0u};
        if (!(zfirst && i < 2)) { r.k[i] = *(const u32x4*)(Kg + (long)row * ldkv + ch * 8); r.v[i] = *(const u32x4*)(Vg + (long)row * ldkv + ch * 8); }
    }
}
__device__ __forceinline__ void kv_store(LAS unsigned char* lds, int tid, const KV8& r) {
#pragma unroll
    for (int i = 0; i < 4; ++i) {
        const int c = tid + 512 * i, row = c >> 3, ch = c & 7;
        *(LAS u32x4*)(lds + K_OFF + row * KSTR + ch * 16) = r.k[i];
        *(LAS u32x4*)(lds + V_OFF + row * VSTR + ch * 16) = r.v[i];
    }
}
__device__ __forceinline__ void swa_head(const int tid, LAS unsigned char* lds, const bf16x8 (&kf)[9][2], const bf16x8 q0, const bf16x8 q1, bool zfirst, float sink, bf16_t* O) {
    const int wid = __builtin_amdgcn_readfirstlane(tid >> 6), lane = tid & 63, fr = lane & 15, fq = lane >> 4;
    f32x4 s[10];
#pragma unroll
    for (int t = 0; t < 9; ++t) {
        s[t] = (f32x4){0.f, 0.f, 0.f, 0.f};
        s[t] = __builtin_amdgcn_mfma_f32_16x16x32_bf16(kf[t][0], q0, s[t], 0, 0, 0);
        s[t] = __builtin_amdgcn_mfma_f32_16x16x32_bf16(kf[t][1], q1, s[t], 0, 0, 0);
    }
    f32x4 m4 = (f32x4){sink, sink, sink, sink};
#pragma unroll
    for (int t = 0; t < 9; ++t) {
        const bool dead = zfirst && (wid + t < 8);
#pragma unroll
        for (int j = 0; j < 4; ++j) {
            bool ok = !dead;
            if (t == 0) ok = ok && (4 * fq + j > fr);
            if (t == 8) ok = ok && (4 * fq + j <= fr);
            if (!ok) s[t][j] = -INFINITY;
            m4[j] = fmaxf(m4[j], s[t][j]);
        }
    }
    const float mx = xrow_max(fmaxf(fmaxf(m4[0], m4[1]), fmaxf(m4[2], m4[3])));
    const float nmxl = -mx * 1.4426950408889634f;
    f32x4 s4 = (f32x4){0.f, 0.f, 0.f, 0.f};
#pragma unroll
    for (int t = 0; t < 9; ++t)
#pragma unroll
        for (int j = 0; j < 4; ++j) { const float e = __builtin_amdgcn_exp2f(__builtin_fmaf(s[t][j], 1.4426950408889634f, nmxl)); s[t][j] = e; s4[j] += e; }
    float sum = xrow_sum((s4[0] + s4[1]) + (s4[2] + s4[3]));
    sum += __builtin_amdgcn_exp2f(__builtin_fmaf(sink, 1.4426950408889634f, nmxl));
    const float inv = 1.f / sum;
    s[9] = (f32x4){0.f, 0.f, 0.f, 0.f};
    f32x4 o[4];
#pragma unroll
    for (int d = 0; d < 4; ++d) o[d] = (f32x4){0.f, 0.f, 0.f, 0.f};
    LAS unsigned char* vb = lds + V_OFF + (16 * wid + 4 * fq + (fr >> 2)) * VSTR + (fr & 3) * 8;
#pragma unroll
    for (int kk = 0; kk < 5; ++kk) {
        const int t0 = 2 * kk, t1 = (kk == 4) ? 8 : 2 * kk + 1;
        const f32x4 p0 = s[2 * kk] * inv, p1 = s[2 * kk + 1] * inv;
        u32x4 pk; pk[0] = cvt_pk_bf16(p0[0], p0[1]); pk[1] = cvt_pk_bf16(p0[2], p0[3]); pk[2] = cvt_pk_bf16(p1[0], p1[1]); pk[3] = cvt_pk_bf16(p1[2], p1[3]);
        const bf16x8 pf = __builtin_bit_cast(bf16x8, pk);
#pragma unroll
        for (int d = 0; d < 4; ++d) {
            const s16x4 v1 = tr_read(vb + (16 * t0) * VSTR + d * 32), v2 = tr_read(vb + (16 * t1) * VSTR + d * 32);
            const bf16x8 vf = __builtin_shufflevector(v1, v2, 0, 1, 2, 3, 4, 5, 6, 7);
            o[d] = __builtin_amdgcn_mfma_f32_16x16x32_bf16(vf, pf, o[d], 0, 0, 0);
        }
    }
    bf16_t* op = O + (long)(16 * wid + fr) * 1024 + 4 * fq;
#pragma unroll
    for (int d = 0; d < 4; ++d) { u32x2 pk; pk[0] = cvt_pk_bf16(o[d][0], o[d][1]); pk[1] = cvt_pk_bf16(o[d][2], o[d][3]); *(u32x2*)(op + 16 * d) = pk; }
}
__device__ __forceinline__ void mem_head(const int tid, LAS unsigned char* lds, const bf16x8 q0, const bf16x8 q1, bf16_t* O) {
    const int wid = __builtin_amdgcn_readfirstlane(tid >> 6), lane = tid & 63, fr = lane & 15, fq = lane >> 4;
    f32x4 s[16];
#pragma unroll
    for (int sub = 0; sub < 16; ++sub) {
        s[sub] = (f32x4){0.f, 0.f, 0.f, 0.f};
        const bf16x8 a0 = *(const LAS bf16x8*)(lds + K_OFF + (16 * sub + fr) * KSTR + fq * 16);
        const bf16x8 a1 = *(const LAS bf16x8*)(lds + K_OFF + (16 * sub + fr) * KSTR + 64 + fq * 16);
        s[sub] = __builtin_amdgcn_mfma_f32_16x16x32_bf16(a0, q0, s[sub], 0, 0, 0);
        s[sub] = __builtin_amdgcn_mfma_f32_16x16x32_bf16(a1, q1, s[sub], 0, 0, 0);
    }
    f32x4 m4 = s[0];
#pragma unroll
    for (int sub = 1; sub < 16; ++sub)
#pragma unroll
        for (int j = 0; j < 4; ++j) m4[j] = fmaxf(m4[j], s[sub][j]);
    float mx = xrow_max(fmaxf(fmaxf(m4[0], m4[1]), fmaxf(m4[2], m4[3])));
    const float nmxl = -mx * 1.4426950408889634f;
    f32x4 s4 = (f32x4){0.f, 0.f, 0.f, 0.f};
#pragma unroll
    for (int sub = 0; sub < 16; ++sub)
#pragma unroll
        for (int j = 0; j < 4; ++j) { const float e = __builtin_amdgcn_exp2f(__builtin_fmaf(s[sub][j], 1.4426950408889634f, nmxl)); s[sub][j] = e; s4[j] += e; }
    float sum = xrow_sum((s4[0] + s4[1]) + (s4[2] + s4[3]));
    const float inv = 1.f / sum;
    f32x4 o[4];
#pragma unroll
    for (int d = 0; d < 4; ++d) o[d] = (f32x4){0.f, 0.f, 0.f, 0.f};
    LAS unsigned char* vb = lds + V_OFF + (4 * fq + (fr >> 2)) * VSTR + (fr & 3) * 8;
#pragma unroll
    for (int kk = 0; kk < 8; ++kk) {
        const f32x4 p0 = s[2 * kk] * inv, p1 = s[2 * kk + 1] * inv;
        u32x4 pk; pk[0] = cvt_pk_bf16(p0[0], p0[1]); pk[1] = cvt_pk_bf16(p0[2], p0[3]); pk[2] = cvt_pk_bf16(p1[0], p1[1]); pk[3] = cvt_pk_bf16(p1[2], p1[3]);
        const bf16x8 pf = __builtin_bit_cast(bf16x8, pk);
#pragma unroll
        for (int d = 0; d < 4; ++d) {
            const s16x4 v1 = tr_read(vb + (32 * kk) * VSTR + d * 32), v2 = tr_read(vb + (32 * kk + 16) * VSTR + d * 32);
            const bf16x8 vf = __builtin_shufflevector(v1, v2, 0, 1, 2, 3, 4, 5, 6, 7);
            o[d] = __builtin_amdgcn_mfma_f32_16x16x32_bf16(vf, pf, o[d], 0, 0, 0);
        }
    }
    bf16_t* op = O + (long)(16 * wid + fr) * 1024 + 4 * fq;
#pragma unroll
    for (int d = 0; d < 4; ++d) { u32x2 pk; pk[0] = cvt_pk_bf16(o[d][0], o[d][1]); pk[1] = cvt_pk_bf16(o[d][2], o[d][3]); *(u32x2*)(op + 16 * d) = pk; }
}
struct AItem { int qb, sel; bool zf; const bf16_t* Kg; const bf16_t* Vg; int ldkv; };
__device__ __forceinline__ bool a_item(const Params& p, int layer, int n, AItem& it) {
    const int k = n >> 1; it.sel = n & 1; it.qb = (int)blockIdx.x + k * (int)gridDim.x;
    if (it.qb >= 512) return false;
    const long tok0 = (long)it.qb * 128;
    it.Kg = (const bf16_t*)(p.ws + WS_BIG) + (size_t)(12 + it.sel) * T_TOK * 64 + (tok0 - 128) * 64; it.Vg = it.Kg + (size_t)2 * T_TOK * 64; it.ldkv = 64; it.zf = (it.qb & 63) == 0;
    return true;
}
__device__ __forceinline__ void mem_part(const int tid_in, const Params& p, LAS unsigned char* lds, int layer, const bf16_t* qbase) {
    int tid = tid_in; asm volatile("" : "+v"(tid));
    const int wid = __builtin_amdgcn_readfirstlane(tid >> 6), lane = tid & 63, fr = lane & 15, fq = lane >> 4;
    const long qlane = (long)(16 * wid + fr) * 64 + fq * 8;
    bf16_t* mix = (bf16_t*)(p.ws + WS_MIX);
    for (int pi = blockIdx.x; pi < 256; pi += gridDim.x) {
        const int combo = pi & 31, slice = pi >> 5, b = combo >> 2, mh = combo & 3;
        const bf16_t* kg = (const bf16_t*)(p.ws + WS_MEMKV) + (long)b * 256 * 2048 + layer * 512 + mh * 64;
        int t2 = tid; asm volatile("" : "+v"(t2));
        KV8 r; kv_load(r, t2, kg, kg + 256, 2048, false);
        const int qb0 = b * 64 + slice * 8;
        bf16x8 qn0, qn1;
        const bf16_t* qh = qbase + (size_t)mh * T_TOK * 64 + qlane;
        { const bf16_t* qp = qh + (long)qb0 * 128 * 64; qn0 = *(const bf16x8*)qp; qn1 = *(const bf16x8*)(qp + 32); }
        __syncthreads();
        kv_store(lds, t2, r);
        __syncthreads();
#pragma nounroll
        for (int i = 0; i < 8; ++i) {
            const bf16x8 q0 = qn0, q1 = qn1;
            if (i + 1 < 8) { const bf16_t* qp = qh + (long)(qb0 + i + 1) * 128 * 64; qn0 = *(const bf16x8*)qp; qn1 = *(const bf16x8*)(qp + 32); }
            mem_head(tid, lds, q0, q1, mix + (long)(qb0 + i) * 128 * 1024 + 768 + mh * 64);
        }
    }
}
__device__ void mix_phase_a(const Params& p, LAS unsigned char* lds, int layer) {
    int tid = threadIdx.x; asm volatile("" : "+v"(tid));
    const int j = layer >> 1;
    const bf16_t* proj = (const bf16_t*)(p.ws + WS_BIG);
    bf16_t* mix = (bf16_t*)(p.ws + WS_MIX);
    const float* sinks = p.in[7] + j * 12;
    const int wid = __builtin_amdgcn_readfirstlane(tid >> 6), lane = tid & 63, fr = lane & 15, fq = lane >> 4;
    const long qlane = (long)(16 * wid + fr) * 64 + fq * 8;
    const int nqb = (512 - (int)blockIdx.x + (int)gridDim.x - 1) / (int)gridDim.x, nh = 12 * nqb;
    KV8 r; AItem it; bf16x8 kf[9][2];
    if (nh > 0) { a_item(p, layer, 0, it); kv_load(r, tid, it.Kg, it.Vg, it.ldkv, it.zf); }
    bf16x8 qn0, qn1;
    if (nh > 0) { const bf16_t* qp = proj + (long)blockIdx.x * 128 * 64 + qlane; qn0 = *(const bf16x8*)qp; qn1 = *(const bf16x8*)(qp + 32); }
    for (int g = 0; g < nh; ++g) {
        const int k = g / 12, hh = g - 12 * k, qb = (int)blockIdx.x + k * (int)gridDim.x;
        const bool zf = (qb & 63) == 0;
        if (hh == 0 || hh == 6) {
            __syncthreads();
            kv_store(lds, tid, r);
            __syncthreads();
            const int gi = (hh < 6) ? 0 : 1;
            if (a_item(p, layer, 2 * k + gi + 1, it)) kv_load(r, tid, it.Kg, it.Vg, it.ldkv, it.zf);
            {
                LAS unsigned char* kb = lds + K_OFF + (16 * wid + fr) * KSTR + fq * 16;
#pragma unroll
                for (int t = 0; t < 9; ++t) { kf[t][0] = *(const LAS bf16x8*)(kb + t * 16 * KSTR); kf[t][1] = *(const LAS bf16x8*)(kb + t * 16 * KSTR + 64); }
            }
        }
        const bf16x8 q0 = qn0, q1 = qn1;
        if (g + 1 < nh) { const int g1 = g + 1, k1 = g1 / 12, hh1 = g1 - 12 * k1, qb1 = (int)blockIdx.x + k1 * (int)gridDim.x;
            const bf16_t* qp = proj + (size_t)hh1 * T_TOK * 64 + (long)qb1 * 128 * 64 + qlane; qn0 = *(const bf16x8*)qp; qn1 = *(const bf16x8*)(qp + 32); }
        bf16_t* O = mix + (long)qb * 128 * 1024 + hh * 64;
        swa_head(tid, lds, kf, q0, q1, zf, sinks[hh], O);
    }
    mem_part(tid, p, lds, layer, proj + (size_t)16 * T_TOK * 64);
}

constexpr int NSTR = 288;
__device__ void mix_phase_b(const Params& p, LAS unsigned char* lds, int layer) {
    int tid = threadIdx.x; asm volatile("" : "+v"(tid));
    const int j = layer >> 1;
    const bf16_t* proj = (const bf16_t*)(p.ws + WS_BIG);
    bf16_t* mix = (bf16_t*)(p.ws + WS_MIX);
    const int wid = __builtin_amdgcn_readfirstlane(tid >> 6), lane = tid & 63, fr = lane & 15, fq = lane >> 4;
    {
        const int NI = 512 * 6;
        u32x4 vr[4];
        f32x4 g0, g1, b0, b1;
        const int lrow = tid >> 4, lch = tid & 15;
        int item = blockIdx.x;
        if (item < NI) { const int cb = item / 6, g = item - 6 * cb;
#pragma unroll
            for (int i = 0; i < 4; ++i) vr[i] = *(const u32x4*)(proj + (size_t)(6 + g) * T_TOK * 128 + ((long)cb * 128 + lrow + 32 * i) * 128 + lch * 8);
            const float* lng = p.in[12] + (j * 6 + g) * 128 + lch * 8; const float* lnb = p.in[13] + (j * 6 + g) * 128 + lch * 8;
            g0 = *(const f32x4*)lng; g1 = *(const f32x4*)(lng + 4); b0 = *(const f32x4*)lnb; b1 = *(const f32x4*)(lnb + 4); }
        for (; item < NI; item += gridDim.x) {
            const int cb = item / 6, g = item - 6 * cb; const long tok0 = (long)cb * 128;
            const int t = 16 * wid + fr;
            const bf16_t* W = (const bf16_t*)(p.ws + WS_BWS) + (size_t)(j * 6 + g) * 128 * 128 + t * 128 + 4 * fq;
            const int nks = (wid >> 1) + 1;
            u32x2 w0[4], w1[4];
#pragma unroll
            for (int ks = 0; ks < 4; ++ks) { w0[ks] = (u32x2){0u, 0u}; w1[ks] = (u32x2){0u, 0u}; if (ks < nks) { w0[ks] = *(const u32x2*)(W + 32 * ks); w1[ks] = *(const u32x2*)(W + 32 * ks + 16); } }
            const float bias = p.in[11][(j * 6 + g) * 128 + t];
            const bf16_t* up = proj + (size_t)g * T_TOK * 128 + (tok0 + t) * 128 + 4 * fq;
            u32x2 ur[8];
#pragma unroll
            for (int d = 0; d < 8; ++d) ur[d] = *(const u32x2*)(up + 16 * d);
            __syncthreads();
#pragma unroll
            for (int i = 0; i < 4; ++i) {
                const u32x4 raw = vr[i];
                float v[8];
#pragma unroll
                for (int e = 0; e < 4; ++e) { v[2 * e] = __uint_as_float(raw[e] << 16); v[2 * e + 1] = __uint_as_float(raw[e] & 0xffff0000u); }
                float sm = 0.f, sq = 0.f;
#pragma unroll
                for (int e = 0; e < 8; ++e) { sm += v[e]; sq += v[e] * v[e]; }
                sm = row16_sum(sm); sq = row16_sum(sq);
                const float mu = sm * (1.f / 128.f);
                const float rs = rsqrtf(fmaxf(sq * (1.f / 128.f) - mu * mu, 0.f) + EPS);
#pragma unroll
                for (int e = 0; e < 8; ++e) v[e] -= mu;
                u32x4 pk;
                pk[0] = cvt_pk_bf16(v[0] * rs * g0[0] + b0[0], v[1] * rs * g0[1] + b0[1]); pk[1] = cvt_pk_bf16(v[2] * rs * g0[2] + b0[2], v[3] * rs * g0[3] + b0[3]);
                pk[2] = cvt_pk_bf16(v[4] * rs * g1[0] + b1[0], v[5] * rs * g1[1] + b1[1]); pk[3] = cvt_pk_bf16(v[6] * rs * g1[2] + b1[2], v[7] * rs * g1[3] + b1[3]);
                *(LAS u32x4*)(lds + (lrow + 32 * i) * NSTR + lch * 16) = pk;
            }
            __syncthreads();
            { const int nitem = item + gridDim.x;
              if (nitem < NI) { const int ncb = nitem / 6, ng = nitem - 6 * ncb;
#pragma unroll
                  for (int i = 0; i < 4; ++i) vr[i] = *(const u32x4*)(proj + (size_t)(6 + ng) * T_TOK * 128 + ((long)ncb * 128 + lrow + 32 * i) * 128 + lch * 8);
                  const float* lng = p.in[12] + (j * 6 + ng) * 128 + lch * 8; const float* lnb = p.in[13] + (j * 6 + ng) * 128 + lch * 8;
                  g0 = *(const f32x4*)lng; g1 = *(const f32x4*)(lng + 4); b0 = *(const f32x4*)lnb; b1 = *(const f32x4*)(lnb + 4); } }
            f32x4 acc[8];
#pragma unroll
            for (int d = 0; d < 8; ++d) acc[d] = (f32x4){0.f, 0.f, 0.f, 0.f};
            LAS unsigned char* vb = lds + (4 * fq + (fr >> 2)) * NSTR + (fr & 3) * 8;
#pragma unroll
            for (int ks = 0; ks < 4; ++ks) {
                if (ks < nks) {
                    u32x4 wp; wp[0] = w0[ks][0]; wp[1] = w0[ks][1]; wp[2] = w1[ks][0]; wp[3] = w1[ks][1];
                    const bf16x8 wf = __builtin_bit_cast(bf16x8, wp);
#pragma unroll
                    for (int d = 0; d < 8; ++d) {
                        const s16x4 v1 = tr_read(vb + (32 * ks) * NSTR + d * 32), v2 = tr_read(vb + (32 * ks + 16) * NSTR + d * 32);
                        const bf16x8 vf = __builtin_shufflevector(v1, v2, 0, 1, 2, 3, 4, 5, 6, 7);
                        acc[d] = __builtin_amdgcn_mfma_f32_16x16x32_bf16(vf, wf, acc[d], 0, 0, 0);
                    }
                }
            }
            bf16_t* op = mix + (tok0 + t) * 1024 + 128 * g + 4 * fq;
#pragma unroll
            for (int d = 0; d < 8; ++d) {
                const float u0 = __uint_as_float(ur[d][0] << 16), u1 = __uint_as_float(ur[d][0] & 0xffff0000u), u2 = __uint_as_float(ur[d][1] << 16), u3 = __uint_as_float(ur[d][1] & 0xffff0000u);
                u32x2 pk; pk[0] = cvt_pk_bf16(u0 * (acc[d][0] + bias), u1 * (acc[d][1] + bias)); pk[1] = cvt_pk_bf16(u2 * (acc[d][2] + bias), u3 * (acc[d][3] + bias));
                *(u32x2*)(op + 16 * d) = pk;
            }
        }
    }
    mem_part(tid, p, lds, layer, proj + (size_t)12 * T_TOK * 128);
}

__device__ void final_phase(const Params& p) {
    int tid = threadIdx.x; asm volatile("" : "+v"(tid));
    const int gw = (blockIdx.x * 512 + tid) >> 6, nw = (gridDim.x * 512) >> 6, lane = tid & 63;
    const unsigned* ss = (const unsigned*)(p.ws + WS_SS) + 8 * 65536; const float* g = p.in[5];
    const bf16_t* h16 = (const bf16_t*)(p.ws + WS_H16);
    const f32x4 g0 = *(const f32x4*)(g + lane * 8), g1 = *(const f32x4*)(g + lane * 8 + 4), g2 = *(const f32x4*)(g + 512 + lane * 8), g3 = *(const f32x4*)(g + 512 + lane * 8 + 4);
    for (int row0 = gw * 4; row0 < T_TOK; row0 += nw * 4) {
        u32x4 a[4], b[4]; unsigned sv[4];
#pragma unroll
        for (int r = 0; r < 4; ++r) { const int row = row0 + r; a[r] = *(const u32x4*)(h16 + (size_t)row * 1024 + lane * 8); b[r] = *(const u32x4*)(h16 + (size_t)row * 1024 + 512 + lane * 8); sv[r] = ss[row]; }
#pragma unroll
        for (int r = 0; r < 4; ++r) { const int row = row0 + r;
            const float rs = rsqrtf((float)sv[r] * SS_INV + EPS);
            f32x4 v0, v1, v2, v3;
            v0[0] = __uint_as_float(a[r][0] << 16); v0[1] = __uint_as_float(a[r][0] & 0xffff0000u); v0[2] = __uint_as_float(a[r][1] << 16); v0[3] = __uint_as_float(a[r][1] & 0xffff0000u);
            v1[0] = __uint_as_float(a[r][2] << 16); v1[1] = __uint_as_float(a[r][2] & 0xffff0000u); v1[2] = __uint_as_float(a[r][3] << 16); v1[3] = __uint_as_float(a[r][3] & 0xffff0000u);
            v2[0] = __uint_as_float(b[r][0] << 16); v2[1] = __uint_as_float(b[r][0] & 0xffff0000u); v2[2] = __uint_as_float(b[r][1] << 16); v2[3] = __uint_as_float(b[r][1] & 0xffff0000u);
            v3[0] = __uint_as_float(b[r][2] << 16); v3[1] = __uint_as_float(b[r][2] & 0xffff0000u); v3[2] = __uint_as_float(b[r][3] << 16); v3[3] = __uint_as_float(b[r][3] & 0xffff0000u);
            float* o = p.out + (size_t)row * 1024 + lane * 8;
            *(f32x4*)o = v0 * rs * g0; *(f32x4*)(o + 4) = v1 * rs * g1; *(f32x4*)(o + 512) = v2 * rs * g2; *(f32x4*)(o + 516) = v3 * rs * g3;
        }
    }
}

__device__ __forceinline__ void run_phase(const Params& p, LAS unsigned char* lds, int ph) {
    unsigned char* ws = p.ws;
    unsigned* ss = (unsigned*)(ws + WS_SS);
    bf16_t* h16 = (bf16_t*)(ws + WS_H16);
    bf16_t* big = (bf16_t*)(ws + WS_BIG);
    bf16_t* mix = (bf16_t*)(ws + WS_MIX);
    if (ph == 0) { for (int rep = 0; rep < PROBE_P0; ++rep) prologue(p, lds); return; }
    if (ph == 1) { EpiProj<2> E; E.O = (bf16_t*)(ws + WS_MEMKV); E.ldc = 2048; E.ss = nullptr;
        run_gemm(lds, (const bf16_t*)(ws + WS_MEMN), (const bf16_t*)(ws + WS_WMKV), 2048, 2048, 1024, E); return; }
    if (ph == NPH - 1) { final_phase(p); return; }
    const int layer = (ph - 2) / 5, sub = (ph - 2) % 5, j = layer >> 1; const bool isB = layer & 1;
    if (sub == 0) {
        if (!isB) { EpiProj<0> E; E.O = big; E.ldc = A_IN; E.ss = ss + (2 * layer) * 65536;
            run_gemm(lds, h16, (const bf16_t*)(ws + WS_WAIN) + (size_t)j * A_IN * 1024, T_TOK, A_IN, 1024, E); }
        else { EpiProj<1> E; E.O = big; E.ldc = B_IN; E.ss = ss + (2 * layer) * 65536;
            run_gemm(lds, h16, (const bf16_t*)(ws + WS_WBIN) + (size_t)j * B_IN * 1024, T_TOK, B_IN, 1024, E); }
    } else if (sub == 1) {
        for (int rep = 0; rep < PROBE_MIX; ++rep) { if (!isB) mix_phase_a(p, lds, layer); else mix_phase_b(p, lds, layer); }
    } else if (sub == 2) {
        const bf16_t* wo = (const bf16_t*)(ws + (isB ? WS_WBOUT : WS_WAOUT)) + (size_t)j * 1024 * 1024;
        if (layer == 0) { EpiRes<1, false> E; E.x = p.in[0]; E.hout = p.out; E.h16 = h16; E.ssout = ss + (2 * layer + 1) * 65536; run_gemm(lds, mix, wo, T_TOK, 1024, 1024, E); }
        else { EpiRes<0, false> E; E.x = nullptr; E.hout = p.out; E.h16 = h16; E.ssout = ss + (2 * layer + 1) * 65536; run_gemm(lds, mix, wo, T_TOK, 1024, 1024, E); }
    } else if (sub == 3) {
        EpiGateUp E; E.O = big; E.ss = ss + (2 * layer + 1) * 65536;
        run_gemm(lds, h16, (const bf16_t*)(ws + WS_WGU) + (size_t)layer * GU_N * 1024, T_TOK, GU_N, 1024, E);
    } else {
        const bf16_t* wd = (const bf16_t*)(ws + WS_WDN) + (size_t)layer * 1024 * DFF;
        { EpiRes<0, false> E; E.x = nullptr; E.hout = p.out; E.h16 = h16; E.ssout = ss + (2 * layer + 2) * 65536; run_gemm(lds, big, wd, T_TOK, 1024, DFF, E); }
    }
}

__global__ void __launch_bounds__(512, 2) mega(Params p) {
    extern __shared__ __attribute__((aligned(16))) unsigned char shm[];
    LAS unsigned char* lds = (LAS unsigned char*)shm;
    volatile LAS unsigned* st = (volatile LAS unsigned*)(lds + LDS_STAGE);
    if (threadIdx.x < 4) st[threadIdx.x] = 0u;
    __syncthreads();
    XcdBarrier bar = xcd_barrier_post((unsigned*)(p.ws + WS_BAR), st);
#pragma unroll
    for (int ph = 0; ph < NPH; ++ph) {
        if (ph >= p.ph_lo && ph < p.ph_hi) {
            if (ph > p.ph_lo) { if (p.ph_hi > NPH) cg::this_grid().sync(); else xcd_barrier(bar); }
            run_phase(p, lds, ph);
        }
    }
}

#ifndef MK_SPLIT
#define MK_SPLIT 0
#endif
extern "C" void kernel_launch(void* const* d_in, const int* in_sizes, int n_in, void* d_out, int out_size, void* d_ws, size_t ws_size, hipStream_t stream) {
    static int grid = 0;
    if (grid == 0) {
        int dev = 0, cus = 0, per_cu = 0;
        hipGetDevice(&dev);
        hipDeviceGetAttribute(&cus, hipDeviceAttributeMultiprocessorCount, dev);
        if (hipFuncSetAttribute((const void*)mega, hipFuncAttributeMaxDynamicSharedMemorySize, LDS_BYTES) != hipSuccess) fprintf(stderr, "kernel_launch: hipFuncSetAttribute failed\n");
        if (hipOccupancyMaxActiveBlocksPerMultiprocessor(&per_cu, (const void*)mega, 512, LDS_BYTES) != hipSuccess || per_cu < 1) { fprintf(stderr, "kernel_launch: occupancy query says %d\n", per_cu); per_cu = 1; }
        (void)hipGetLastError();
        grid = cus * per_cu;
        if (ws_size < WS_TOTAL) fprintf(stderr, "kernel_launch: workspace too small: %zu < %zu\n", ws_size, (size_t)WS_END);
    }
    hipMemsetAsync((char*)d_ws + WS_BAR, 0, XCD_BAR_WORDS * 4, stream);
    Params p{};
    for (int i = 0; i < 18; ++i) p.in[i] = (const float*)d_in[i];
    p.out = (float*)d_out; p.ws = (unsigned char*)d_ws;
#if MK_SPLIT
    for (int ph = 0; ph < NPH; ++ph) { p.ph_lo = ph; p.ph_hi = ph + 1; hipLaunchKernelGGL(mega, dim3(grid), dim3(512), LDS_BYTES, stream, p); }
#else
    p.ph_lo = 0; p.ph_hi = NPH;
    void* args[] = {&p};
    hipError_t e = hipLaunchCooperativeKernel((const void*)mega, dim3(grid), dim3(512), args, LDS_BYTES, stream);
    if (e != hipSuccess) fprintf(stderr, "cooperative launch failed: %s (grid %d)\n", hipGetErrorString(e), grid);
#endif
}
```

```cpp
#include <hip/hip_runtime.h>
#include <hip/hip_cooperative_groups.h>
#include <cstdio>
namespace cg = cooperative_groups;
namespace pg8 {
#define PG8_LAS __attribute__((address_space(3)))
typedef unsigned short bf16_t;
typedef short bf16x8 __attribute__((ext_vector_type(8)));
typedef float f32x4 __attribute__((ext_vector_type(4)));
typedef unsigned u32x4 __attribute__((ext_vector_type(4)));
constexpr int BM = 256, BK = 64, HALF = 128, HTB = HALF * BK * 2  , STAGE_BYTES = 8 * HTB, NXCD = 8, WGM = 4;

__host__ __device__ __forceinline__ int lds_byte(int r, int c) { const int st = (r >> 4) * 2 + (c >> 5), rr = r & 15, cc = c & 31, ob = rr * 64 + cc * 2; return st * 1024 + (ob ^ (((ob >> 9) & 1) << 5)); }
__host__ __device__ __forceinline__ void stage_rc(int b, int& R, int& C) { const int st = b / 1024, sb = b % 1024, swz = sb ^ (((sb >> 9) & 1) << 5); R = (st >> 1) * 16 + swz / 64; C = (st & 1) * 32 + (swz % 64) / 2; }
__host__ __device__ __forceinline__ int perm32(int rho) { const int n = rho >> 4, i = rho & 15; return 8 * (i >> 2) + 4 * n + (i & 3); }
struct Unit { int pm, pn; };
struct Gemm { const bf16_t* A; const bf16_t* Bt; int M, N, K; };
struct StaticOrder {
    int nM, nN, nwg, G, c;
    __host__ __device__ void init(int M, int N, int G_, int c_) { nM = M / BM; nN = N / BM; nwg = nM * nN; G = G_; c = c_; }
    __host__ __device__ bool next(int i, Unit& u) const {
        const long L = (long)i * G + c; if (L >= nwg) return false;
        int wgid = (int)L; { const int q = nwg / NXCD, r = nwg % NXCD, xcd = wgid % NXCD, off = wgid / NXCD; wgid = (xcd < r ? xcd * (q + 1) : r * (q + 1) + (xcd - r) * q) + off; }
        const int nig = WGM * nN, gid = wgid / nig, fm = gid * WGM, gsz = (nM - fm) < WGM ? (nM - fm) : WGM;
        u.pm = fm + ((wgid % nig) % gsz); u.pn = (wgid % nig) / gsz; return true;
    }
    __device__ __forceinline__ void a_ready(const Unit&) const {}
    __device__ __forceinline__ void done(const Unit&) const {}
};
typedef float f32x2_t __attribute__((ext_vector_type(2)));
typedef __bf16 bf16x2_t __attribute__((ext_vector_type(2)));
__device__ __forceinline__ unsigned cvt_pk_bf16(float lo, float hi) { const f32x2_t v = {lo, hi}; const bf16x2_t b = __builtin_convertvector(v, bf16x2_t); return __builtin_bit_cast(unsigned, b); }
template <class Epi, class Sched, bool STAMP = false>
__device__ __forceinline__ void gemm_phase(PG8_LAS unsigned char* lds, const Gemm g, const Sched& S, const Epi& E, unsigned* stamps) {
    int tid_ = threadIdx.x; asm volatile("" : "+v"(tid_));
    const int tid = tid_, wid = __builtin_amdgcn_readfirstlane(tid >> 6), lane = tid & 63, wr = wid >> 2, wc = wid & 3, fr = lane & 15, fq = lane >> 4;
    const int K = g.K, nt = K / BK;
    int ts_lo = 0, ts_hi = 0, nts = 0; const unsigned rt_entry = STAMP ? (unsigned)wall_clock64() : 0ull;
#define PG8_STAMP() do { if (STAMP && wid == 0 && nts < 64) { const unsigned _c = (unsigned)clock64(); \
        ts_lo = (lane == nts) ? (int)(unsigned)_c : ts_lo; ts_hi = (lane == nts) ? (int)(unsigned)(_c >> 32) : ts_hi; ++nts; } } while (0)
    PG8_STAMP();
    unsigned voffA[2], voffB[2];
#pragma unroll
    for (int i = 0; i < 2; ++i) { int R, C; stage_rc(tid * 16 + i * 8192, R, C); const int Rb = Epi::PERM ? ((R & ~31) + perm32(R & 31)) : R;
        voffA[i] = (unsigned)(R * K + C) * 2u; voffB[i] = (unsigned)(Rb * K + C) * 2u; }
    const size_t kstep = (size_t)(BK * 2);
    const size_t hstep = (size_t)HALF * K * 2;
    const size_t tstep = 2 * hstep;
    const unsigned ldsw = (unsigned)wid * 1024u;
    const int aoff = lds_byte(wr * 64 + fr, fq * 8), boff = lds_byte(wc * 32 + fr, fq * 8);
#define PG8_SA(b, h) (((b) * 2 + (h)) * HTB)
#define PG8_SB(b, h) ((4 + (b) * 2 + (h)) * HTB)
#define PG8_STAGE(bufoff, gbase, voff) do { _Pragma("unroll") for (int _i = 0; _i < 2; ++_i) \
        __builtin_amdgcn_global_load_lds((const unsigned*)((const char*)(gbase) + (voff)[_i]), (PG8_LAS unsigned*)(lds + (bufoff) + ldsw + _i * 8192), 16, 0, 0); } while (0)
#define PG8_LDA(dst, b, h) do { _Pragma("unroll") for (int m = 0; m < 4; ++m) _Pragma("unroll") for (int k = 0; k < 2; ++k) dst[m][k] = *(const PG8_LAS bf16x8*)(lds + PG8_SA(b, h) + aoff + m * 2048 + k * 1024); } while (0)
#define PG8_LDB(dst, b, h) do { _Pragma("unroll") for (int n = 0; n < 2; ++n) _Pragma("unroll") for (int k = 0; k < 2; ++k) dst[n][k] = *(const PG8_LAS bf16x8*)(lds + PG8_SB(b, h) + boff + n * 2048 + k * 1024); } while (0)
#define PG8_MMA(ai, bj, At, Bt) do { __builtin_amdgcn_s_setprio(1); _Pragma("unroll") for (int m = 0; m < 4; ++m) _Pragma("unroll") for (int n = 0; n < 2; ++n) _Pragma("unroll") for (int k = 0; k < 2; ++k) \
        acc[ai][bj][m][n] = __builtin_amdgcn_mfma_f32_16x16x32_bf16(Bt[n][k], At[m][k], acc[ai][bj][m][n], 0, 0, 0); __builtin_amdgcn_s_setprio(0); } while (0)
#define PG8_WAIT_V(n) asm volatile("s_waitcnt vmcnt(" #n ")" ::: "memory")
#define PG8_WAIT_L(n) asm volatile("s_waitcnt lgkmcnt(" #n ")" ::: "memory")
#define PG8_BAR __builtin_amdgcn_s_barrier()
#define PG8_SCHED __builtin_amdgcn_sched_barrier(0)
    Unit cur, nxt; int ui = 0;
    if (!S.next(0, cur)) return;
    f32x4 acc[2][2][4][2];
#pragma unroll
    for (int a = 0; a < 2; ++a)
#pragma unroll
        for (int b = 0; b < 2; ++b)
#pragma unroll
            for (int m = 0; m < 4; ++m)
#pragma unroll
                for (int n = 0; n < 2; ++n) acc[a][b][m][n] = (f32x4){0.f, 0.f, 0.f, 0.f};
    bf16x8 At[4][2], B0[2][2], B1[2][2];
    const char* cA = (const char*)g.A + (size_t)cur.pm * tstep; const char* cB = (const char*)g.Bt + (size_t)cur.pn * tstep;
    S.a_ready(cur);
    PG8_STAGE(PG8_SB(0, 0), cB, voffB); PG8_STAGE(PG8_SA(0, 0), cA, voffA); PG8_STAGE(PG8_SB(0, 1), cB + hstep, voffB); PG8_STAGE(PG8_SA(0, 1), cA + hstep, voffA);
    if (wr == 1) PG8_BAR;
    PG8_WAIT_V(4); PG8_BAR;
    PG8_STAGE(PG8_SB(1, 0), cB + kstep, voffB); PG8_STAGE(PG8_SA(1, 0), cA + kstep, voffA); PG8_STAGE(PG8_SB(1, 1), cB + hstep + kstep, voffB);
    PG8_WAIT_V(6); PG8_BAR;
    PG8_STAMP();
    unsigned pre[8];
    for (;;) {
        E.pre(cur, wr, fr, pre);
        const bool has_next = S.next(ui + 1, nxt);
        const char* nA = has_next ? (const char*)g.A + (size_t)nxt.pm * tstep : cA; const char* nB = has_next ? (const char*)g.Bt + (size_t)nxt.pn * tstep : cB;
        for (int t = 0; t < nt; t += 2) {
            const bool last = (t == nt - 2);
            const char* a1 = cA + (size_t)(t + 1) * kstep;
            const char* a2 = last ? nA : cA + (size_t)(t + 2) * kstep; const char* b2 = last ? nB : cB + (size_t)(t + 2) * kstep;
            const char* a3 = a2 + kstep; const char* b3 = b2 + kstep;
            if (last && has_next) S.a_ready(nxt);
            PG8_LDB(B0, 0, 0); PG8_SCHED; PG8_LDA(At, 0, 0); PG8_STAGE(PG8_SA(1, 1), a1 + hstep, voffA);
            PG8_WAIT_L(8); PG8_BAR; PG8_WAIT_L(0); PG8_MMA(0, 0, At, B0); PG8_BAR; PG8_SCHED;
            PG8_LDB(B1, 0, 1); PG8_STAGE(PG8_SB(0, 0), b2, voffB);
            PG8_BAR; PG8_WAIT_L(0); PG8_MMA(0, 1, At, B1); PG8_BAR;
            PG8_LDA(At, 0, 1); PG8_STAGE(PG8_SA(0, 0), a2, voffA);
            PG8_BAR; PG8_WAIT_L(0); PG8_MMA(1, 0, At, B0); PG8_BAR; PG8_SCHED;
            PG8_STAGE(PG8_SB(0, 1), b2 + hstep, voffB);
            PG8_WAIT_V(6); PG8_BAR; PG8_MMA(1, 1, At, B1); PG8_BAR;
            PG8_LDB(B0, 1, 0); PG8_SCHED; PG8_LDA(At, 1, 0); PG8_STAGE(PG8_SA(0, 1), a2 + hstep, voffA);
            PG8_WAIT_L(8); PG8_BAR; PG8_WAIT_L(0); PG8_MMA(0, 0, At, B0); PG8_BAR; PG8_SCHED;
            PG8_LDB(B1, 1, 1); PG8_STAGE(PG8_SB(1, 0), b3, voffB);
            PG8_BAR; PG8_WAIT_L(0); PG8_MMA(0, 1, At, B1); PG8_BAR;
            PG8_LDA(At, 1, 1); PG8_STAGE(PG8_SA(1, 0), a3, voffA);
            PG8_BAR; PG8_WAIT_L(0); PG8_MMA(1, 0, At, B0); PG8_BAR; PG8_SCHED;
            PG8_STAGE(PG8_SB(1, 1), b3 + hstep, voffB);
            PG8_WAIT_V(6); PG8_BAR; PG8_MMA(1, 1, At, B1); PG8_BAR;
        }
        PG8_STAMP();
        if constexpr (!Epi::AFTER_DRAIN) { E(acc, cur, wr, wc, fr, fq, pre); S.done(cur); }
        PG8_STAMP();
        if (!has_next) break;
#pragma unroll
        for (int a = 0; a < 2; ++a)
#pragma unroll
            for (int b = 0; b < 2; ++b)
#pragma unroll
                for (int m = 0; m < 4; ++m)
#pragma unroll
                    for (int n = 0; n < 2; ++n) acc[a][b][m][n] = (f32x4){0.f, 0.f, 0.f, 0.f};
        cur = nxt; cA = nA; cB = nB; ++ui;
    }
    PG8_WAIT_V(0);
    if (wr == 0) PG8_BAR;
    PG8_BAR;
    if constexpr (Epi::AFTER_DRAIN) { E.fused(acc, cur, wr, wc, fr, fq, lds, wid, lane); S.done(cur); }
    PG8_STAMP();
    if (STAMP && wid == 0) { stamps[lane] = lane < nts ? (((unsigned)(unsigned)ts_hi << 32) | (unsigned)ts_lo) : 0ull;
        if (lane == 62) stamps[62] = rt_entry; if (lane == 63) stamps[63] = (unsigned)wall_clock64(); }
#undef PG8_STAMP
#undef PG8_SA
#undef PG8_SB
#undef PG8_STAGE
#undef PG8_LDA
#undef PG8_LDB
#undef PG8_MMA
#undef PG8_WAIT_V
#undef PG8_WAIT_L
#undef PG8_BAR
#undef PG8_SCHED
}
}

using pg8::bf16_t; using pg8::bf16x8; using pg8::f32x4; using pg8::u32x4; using pg8::Unit; using pg8::cvt_pk_bf16;
#define LAS PG8_LAS
typedef short s16x4 __attribute__((ext_vector_type(4)));
typedef unsigned u32x2 __attribute__((ext_vector_type(2)));

constexpr int T_TOK = 65536, SEQ = 8192;
constexpr int A_IN = 1280, B_IN = 1792, DFF = 2816, GU_N = 5632;
constexpr float EPS = 1e-6f;
constexpr float SS_SCALE = 64.f, SS_INV = 1.f / (64.f * 1024.f);
constexpr int LDS_STAGE = 131072, LDS_BYTES = LDS_STAGE + 16;
constexpr int NPH = 23;
#ifndef PROBE_MIX
#define PROBE_MIX 1
#endif
#ifndef PROBE_X
#define PROBE_X 1
#endif
#ifndef PROBE_P0
#define PROBE_P0 1
#endif

constexpr size_t WS_WAIN  = 0;
constexpr size_t WS_WBIN  = WS_WAIN  + 2ull * 1280 * 1024 * 2;
constexpr size_t WS_WAOUT = WS_WBIN  + 2ull * 1792 * 1024 * 2;
constexpr size_t WS_WBOUT = WS_WAOUT + 2ull * 1024 * 1024 * 2;
constexpr size_t WS_WMKV  = WS_WBOUT + 2ull * 1024 * 1024 * 2;
constexpr size_t WS_WGU   = WS_WMKV  + 2048ull * 1024 * 2;
constexpr size_t WS_WDN   = WS_WGU   + 4ull * 5632 * 1024 * 2;
constexpr size_t WS_BWS   = WS_WDN   + 4ull * 1024 * 2816 * 2;
constexpr size_t WS_MEMN  = WS_BWS   + 2ull * 6 * 128 * 128 * 2;
constexpr size_t WS_MEMKV = WS_MEMN  + 2048ull * 1024 * 2;
constexpr size_t WS_SS    = WS_MEMKV + 2048ull * 2048 * 2;
constexpr size_t WS_H16   = WS_SS    + 9ull * 65536 * 4;
constexpr size_t WS_BIG   = WS_H16   + 65536ull * 1024 * 2;
constexpr size_t WS_MIX   = WS_BIG   + 65536ull * 1792 * 2;
constexpr size_t WS_END   = WS_BIG   + 65536ull * 2816 * 2;
constexpr size_t WS_BAR   = WS_END;
constexpr size_t WS_TOTAL = WS_BAR + 3456 * 4;

#define XB_TMO      128
#define XB_XCNT(j)  (256  + 64 * (j))
#define XB_XSUB(j)  (1280 + 64 * (j))
#define XB_XGEN(j)  (2304 + 64 * (j))
#define XB_TOP      3328
#define XB_TOPGEN   3392
#define XCD_BAR_WORDS 3456
#define XB_SPIN_CAP (1u << 18)

__device__ __forceinline__ unsigned xb_ld(unsigned* p)              { return __hip_atomic_load(p, __ATOMIC_RELAXED, __HIP_MEMORY_SCOPE_AGENT); }
__device__ __forceinline__ unsigned xb_add(unsigned* p, unsigned v) { return __hip_atomic_fetch_add(p, v, __ATOMIC_RELAXED, __HIP_MEMORY_SCOPE_AGENT); }
__device__ __forceinline__ unsigned xb_xcc_id() { return (unsigned)__builtin_amdgcn_s_getreg((3 << 11) | 20) & 0xFu; }
#define XB_SPIN(cond, bar) do { unsigned _sp = 0; while (cond) { __builtin_amdgcn_s_sleep(1); \
    if ((++_sp & 255u) == 0u) { if (xb_ld(&(bar)[XB_TMO])) break; if (_sp > XB_SPIN_CAP) { atomicAdd(&(bar)[XB_TMO], 1u); break; } } } } while (0)

struct XcdBarrier {
    unsigned* bar; unsigned x;
    volatile LAS unsigned* st;
};

__device__ __forceinline__ XcdBarrier xcd_barrier_post(unsigned* bar, volatile LAS unsigned* st) {
    XcdBarrier b; b.bar = bar; b.x = xb_xcc_id(); b.st = st;
    if (threadIdx.x == 0) (void)xb_add(&bar[XB_XCNT(b.x)], 1u);
    return b;
}
__device__ __forceinline__ void xcd_barrier_complete(unsigned* bar, unsigned x, unsigned& nloc, unsigned& nx) {
    const unsigned G = gridDim.x * gridDim.y * gridDim.z;
    unsigned sum, cnt, mine, sp = 0u;
    for (;;) {
        sum = 0u; cnt = 0u; mine = 0u;
#pragma unroll
        for (unsigned j = 0; j < 16; ++j) { const unsigned c = xb_ld(&bar[XB_XCNT(j)]); sum += c; cnt += (c > 0u) ? 1u : 0u; mine = (j == x) ? c : mine; }
        if (sum == G) break;
        __builtin_amdgcn_s_sleep(1);
        if ((++sp & 255u) == 0u) { if (xb_ld(&bar[XB_TMO])) break; if (sp > XB_SPIN_CAP) { atomicAdd(&bar[XB_TMO], 1u); break; } }
    }
    nloc = mine > 0u ? mine : 1u; nx = cnt > 0u ? cnt : 1u;
}

__device__ __forceinline__ void xcd_barrier(const XcdBarrier& b) {
    asm volatile("s_waitcnt vmcnt(0)" ::: "memory");
    __syncthreads();
    if (threadIdx.x == 0) {
        unsigned* bar = b.bar;
        __builtin_amdgcn_s_waitcnt(0);
        unsigned nloc = b.st[0], nx = b.st[1];
        if (nloc == 0u) { xcd_barrier_complete(bar, b.x, nloc, nx); b.st[0] = nloc; b.st[1] = nx; }
        const unsigned old = xb_add(&bar[XB_XSUB(b.x)], 1u);
        const unsigned gen = old / nloc;
        if (old + 1u == (gen + 1u) * nloc) {
            __builtin_amdgcn_fence(__ATOMIC_RELEASE, "agent");
            asm volatile("s_waitcnt vmcnt(0)" ::: "memory");
            const unsigned og = xb_add(&bar[XB_TOP], 1u);
            const unsigned tg = og / nx;
            if (og + 1u == (tg + 1u) * nx) xb_add(&bar[XB_TOPGEN], 1u);
            else XB_SPIN(xb_ld(&bar[XB_TOPGEN]) == tg, bar);
            __builtin_amdgcn_fence(__ATOMIC_ACQUIRE, "agent");
            xb_add(&bar[XB_XGEN(b.x)], 1u);
            asm volatile("s_waitcnt vmcnt(0)" ::: "memory");
        } else {
            XB_SPIN(xb_ld(&bar[XB_XGEN(b.x)]) == gen, bar);
            __builtin_amdgcn_fence(__ATOMIC_ACQUIRE, "agent");
            asm volatile("s_waitcnt vmcnt(0)" ::: "memory");
        }
    }
    __syncthreads();
}


struct Params { const float* in[18]; float* out; unsigned char* ws; int ph_lo, ph_hi; };

__device__ __forceinline__ float bf2f(unsigned short b) { return __uint_as_float(((unsigned)b) << 16); }
__device__ __forceinline__ float wave_sum(float v) {
#pragma unroll
    for (int o = 32; o; o >>= 1) v += __shfl_xor(v, o);
    return v;
}
__device__ __forceinline__ float row16_sum(float v) {
    v += __int_as_float(__builtin_amdgcn_update_dpp(0, __float_as_int(v), 0xB1, 0xF, 0xF, false));
    v += __int_as_float(__builtin_amdgcn_update_dpp(0, __float_as_int(v), 0x4E, 0xF, 0xF, false));
    v += __int_as_float(__builtin_amdgcn_update_dpp(0, __float_as_int(v), 0x124, 0xF, 0xF, false));
    v += __int_as_float(__builtin_amdgcn_update_dpp(0, __float_as_int(v), 0x128, 0xF, 0xF, false));
    return v;
}
__device__ __forceinline__ float xrow_sum(float x) {
    const auto a = __builtin_amdgcn_permlane16_swap(__float_as_uint(x), __float_as_uint(x), false, false);
    x = __uint_as_float(a[0]) + __uint_as_float(a[1]);
    const auto b = __builtin_amdgcn_permlane32_swap(__float_as_uint(x), __float_as_uint(x), false, false);
    return __uint_as_float(b[0]) + __uint_as_float(b[1]);
}
__device__ __forceinline__ float xrow_max(float x) {
    const auto a = __builtin_amdgcn_permlane16_swap(__float_as_uint(x), __float_as_uint(x), false, false);
    x = fmaxf(__uint_as_float(a[0]), __uint_as_float(a[1]));
    const auto b = __builtin_amdgcn_permlane32_swap(__float_as_uint(x), __float_as_uint(x), false, false);
    return fmaxf(__uint_as_float(b[0]), __uint_as_float(b[1]));
}
__device__ __forceinline__ float gelu_t(float x) {
    const float u = 0.7978845608028654f * x * (1.f + 0.044715f * x * x);
    const float e = __builtin_amdgcn_exp2f(-2.885390081777927f * u);
    return x * __builtin_amdgcn_rcpf(1.f + e);
}

template <int MODE> struct EpiProj {
    static constexpr bool PERM = true, AFTER_DRAIN = false;
    bf16_t* O; int ldc; const unsigned* ss;
    __device__ __forceinline__ void pre(const Unit& u, int wr, int fr, unsigned (&pr)[8]) const {
        if (MODE != 2) {
#pragma unroll
            for (int i = 0; i < 8; ++i) pr[i] = ss[u.pm * 256 + wr * 64 + fr + (i >> 2) * 128 + (i & 3) * 16];
        }
    }
    __device__ __forceinline__ void operator()(const f32x4 (&acc)[2][2][4][2], const Unit& u, int wr, int wc, int fr, int fq, const unsigned (&pr)[8]) const {
        const int row0 = u.pm * 256 + wr * 64 + fr, col0 = u.pn * 256 + wc * 32 + 8 * fq;
        const bool act = (MODE == 1) && (u.pn < 6);
#pragma unroll
        for (int ai = 0; ai < 2; ++ai)
#pragma unroll
            for (int m = 0; m < 4; ++m) {
                const int row = row0 + ai * 128 + m * 16;
                float rs = 1.f; if (MODE != 2) rs = rsqrtf((float)pr[ai * 4 + m] * SS_INV + EPS);
#pragma unroll
                for (int bj = 0; bj < 2; ++bj) {
                    f32x4 v0 = acc[ai][bj][m][0] * rs, v1 = acc[ai][bj][m][1] * rs;
                    if (act) {
#pragma unroll
                        for (int e = 0; e < 4; ++e) { v0[e] = gelu_t(v0[e]); v1[e] = gelu_t(v1[e]); }
                    }
                    u32x4 pk; pk[0] = cvt_pk_bf16(v0[0], v0[1]); pk[1] = cvt_pk_bf16(v0[2], v0[3]); pk[2] = cvt_pk_bf16(v1[0], v1[1]); pk[3] = cvt_pk_bf16(v1[2], v1[3]);
                    const int c = col0 + bj * 128;
                    bf16_t* dstp;
                    if (MODE == 0) dstp = O + (size_t)(c >> 6) * ((size_t)T_TOK * 64) + (size_t)row * 64 + (c & 63);
                    else if (MODE == 1) dstp = (c < 1536) ? O + (size_t)(c >> 7) * ((size_t)T_TOK * 128) + (size_t)row * 128 + (c & 127)
                                                          : O + (size_t)12 * T_TOK * 128 + (size_t)((c - 1536) >> 6) * ((size_t)T_TOK * 64) + (size_t)row * 64 + (c & 63);
                    else dstp = O + (size_t)row * ldc + c;
                    *(u32x4*)dstp = pk;
                }
            }
    }
};
struct EpiGateUp {
    static constexpr bool PERM = true, AFTER_DRAIN = false;
    bf16_t* O; const unsigned* ss;
    __device__ __forceinline__ void pre(const Unit& u, int wr, int fr, unsigned (&pr)[8]) const {
#pragma unroll
        for (int i = 0; i < 8; ++i) pr[i] = ss[u.pm * 256 + wr * 64 + fr + (i >> 2) * 128 + (i & 3) * 16];
    }
    __device__ __forceinline__ void operator()(const f32x4 (&acc)[2][2][4][2], const Unit& u, int wr, int wc, int fr, int fq, const unsigned (&pr)[8]) const {
        const int row0 = u.pm * 256 + wr * 64 + fr, col0 = u.pn * 128 + wc * 32 + 8 * fq;
#pragma unroll
        for (int ai = 0; ai < 2; ++ai)
#pragma unroll
            for (int m = 0; m < 4; ++m) {
                const int row = row0 + ai * 128 + m * 16;
                const float rs = rsqrtf((float)pr[ai * 4 + m] * SS_INV + EPS);
                float o[8];
#pragma unroll
                for (int bj = 0; bj < 2; ++bj) {
                    const f32x4 g = acc[ai][bj][m][0] * rs, up = acc[ai][bj][m][1] * rs;
#pragma unroll
                    for (int e = 0; e < 4; ++e) o[4 * bj + e] = g[e] * up[e] * __builtin_amdgcn_rcpf(1.f + __builtin_amdgcn_exp2f(-1.4426950408889634f * g[e]));
                }
                u32x4 pk; pk[0] = cvt_pk_bf16(o[0], o[1]); pk[1] = cvt_pk_bf16(o[2], o[3]); pk[2] = cvt_pk_bf16(o[4], o[5]); pk[3] = cvt_pk_bf16(o[6], o[7]);
                *(u32x4*)(O + (size_t)row * DFF + col0) = pk;
            }
    }
};
template <int SRC, bool F32OUT> struct EpiRes {
    static constexpr bool PERM = true, AFTER_DRAIN = false;
    const float* x; float* hout; bf16_t* h16; unsigned* ssout;
    __device__ __forceinline__ void pre(const Unit&, int, int, unsigned (&)[8]) const {}
    __device__ __forceinline__ void row_out(const f32x4 (&acc)[2][2][4][2], int ai, int m, int row, int col0, f32x4 (&v)[2][2], int fq) const {
        bf16_t* bp = h16 + (size_t)row * 1024 + col0;
        float sq = 0.f;
#pragma unroll
        for (int bj = 0; bj < 2; ++bj) {
            const f32x4 v0 = v[bj][0] + acc[ai][bj][m][0], v1 = v[bj][1] + acc[ai][bj][m][1];
            if (F32OUT) { float* op = hout + (size_t)row * 1024 + col0 + bj * 128; *(f32x4*)op = v0; *(f32x4*)(op + 4) = v1; }
            else { u32x4 pk; pk[0] = cvt_pk_bf16(v0[0], v0[1]); pk[1] = cvt_pk_bf16(v0[2], v0[3]); pk[2] = cvt_pk_bf16(v1[0], v1[1]); pk[3] = cvt_pk_bf16(v1[2], v1[3]);
                *(u32x4*)(bp + bj * 128) = pk; }
            sq += ((v0[0] * v0[0] + v0[1] * v0[1]) + (v0[2] * v0[2] + v0[3] * v0[3])) + ((v1[0] * v1[0] + v1[1] * v1[1]) + (v1[2] * v1[2] + v1[3] * v1[3]));
        }
        sq = xrow_sum(sq);
        if (fq == 0) atomicAdd(ssout + row, (unsigned)(sq * SS_SCALE));
    }
    __device__ __forceinline__ void unpack(const u32x4 r, f32x4 (&v)[2]) const {
        v[0][0] = __uint_as_float(r[0] << 16); v[0][1] = __uint_as_float(r[0] & 0xffff0000u); v[0][2] = __uint_as_float(r[1] << 16); v[0][3] = __uint_as_float(r[1] & 0xffff0000u);
        v[1][0] = __uint_as_float(r[2] << 16); v[1][1] = __uint_as_float(r[2] & 0xffff0000u); v[1][2] = __uint_as_float(r[3] << 16); v[1][3] = __uint_as_float(r[3] & 0xffff0000u);
    }
    __device__ __forceinline__ void operator()(const f32x4 (&acc)[2][2][4][2], const Unit& u, int wr, int wc, int fr, int fq, const unsigned (&)[8]) const {
        const int row0 = u.pm * 256 + wr * 64 + fr, col0 = u.pn * 256 + wc * 32 + 8 * fq;
        if (SRC == 0) {
#pragma unroll
            for (int ai = 0; ai < 2; ++ai) {
                u32x4 ra[4][2];
#pragma unroll
                for (int m = 0; m < 4; ++m)
#pragma unroll
                    for (int bj = 0; bj < 2; ++bj) ra[m][bj] = *(const u32x4*)(h16 + (size_t)(row0 + ai * 128 + m * 16) * 1024 + col0 + bj * 128);
#pragma unroll
                for (int m = 0; m < 4; ++m) { f32x4 v[2][2]; unpack(ra[m][0], v[0]); unpack(ra[m][1], v[1]); row_out(acc, ai, m, row0 + ai * 128 + m * 16, col0, v, fq); }
            }
        } else {
#pragma unroll
            for (int ai = 0; ai < 2; ++ai) {
                f32x4 xf[4][2][2];
#pragma unroll
                for (int m = 0; m < 4; ++m)
#pragma unroll
                    for (int bj = 0; bj < 2; ++bj) { const float* ip = x + (size_t)(row0 + ai * 128 + m * 16) * 1024 + col0 + bj * 128; xf[m][bj][0] = *(const f32x4*)ip; xf[m][bj][1] = *(const f32x4*)(ip + 4); }
#pragma unroll
                for (int m = 0; m < 4; ++m) row_out(acc, ai, m, row0 + ai * 128 + m * 16, col0, xf[m], fq);
            }
        }
    }
};

template <class Epi> __device__ __forceinline__ void run_gemm(LAS unsigned char* lds, const bf16_t* A, const bf16_t* Bt, int M, int N, int K, const Epi& E) {
    pg8::Gemm g; g.A = A; g.Bt = Bt; g.M = M; g.N = N; g.K = K;
    pg8::StaticOrder S; S.init(M, N, (int)gridDim.x, (int)blockIdx.x);
    pg8::gemm_phase<Epi, pg8::StaticOrder, false>(lds, g, S, E, nullptr);
}

__device__ __forceinline__ void conv_tile(const int tid, LAS float* t, const float* src, bf16_t* dst, int K, int N, const float* gain, int mode, int tile) {
    const int ntn = N >> 6, tk = tile / ntn, tn = tile - tk * ntn, k0 = tk * 64, n0 = tn * 64;
    {
        const int kr = tid >> 3, nc = (tid & 7) * 8;
        const float* s = src + (size_t)(k0 + kr) * N + n0 + nc;
        const f32x4 a = *(const f32x4*)s, b = *(const f32x4*)(s + 4);
        const float gs = gain ? gain[k0 + kr] : 1.f;
        LAS float* tp = t + kr * 65 + nc;
        tp[0] = a[0] * gs; tp[1] = a[1] * gs; tp[2] = a[2] * gs; tp[3] = a[3] * gs; tp[4] = b[0] * gs; tp[5] = b[1] * gs; tp[6] = b[2] * gs; tp[7] = b[3] * gs;
    }
    __syncthreads();
    {
        const int nr = tid >> 3, kc = (tid & 7) * 8, n = n0 + nr;
        float cs = 1.f;
        if (mode == 1 && (n < 768 || n >= 1024)) cs = 0.125f;
        if (mode == 2 && n >= 1536) cs = 0.125f;
        int drow = n;
        if (mode == 3) { const int up = (n >= DFF) ? 1 : 0, j = n - DFF * up, r = j & 127; drow = 256 * (j >> 7) + 128 * ((r >> 2) & 1) + 32 * (r >> 5) + 8 * ((r >> 3) & 3) + 4 * up + (r & 3); }
        float v[8];
#pragma unroll
        for (int e = 0; e < 8; ++e) v[e] = t[(kc + e) * 65 + nr] * cs;
        u32x4 pk; pk[0] = cvt_pk_bf16(v[0], v[1]); pk[1] = cvt_pk_bf16(v[2], v[3]); pk[2] = cvt_pk_bf16(v[4], v[5]); pk[3] = cvt_pk_bf16(v[6], v[7]);
        *(u32x4*)(dst + (size_t)drow * K + k0 + kc) = pk;
    }
    __syncthreads();
}
__device__ __forceinline__ void conv_job(const int tid, LAS float* t, const float* src, bf16_t* dst, int K, int N, const float* gain, int mode) {
    const int nt = (K >> 6) * (N >> 6);
    for (int tile = blockIdx.x; tile < nt; tile += gridDim.x) conv_tile(tid, t, src, dst, K, N, gain, mode, tile);
}

__device__ void prologue(const Params& p, LAS unsigned char* lds) {
    LAS float* t = (LAS float*)lds;
    unsigned char* ws = p.ws;
    int tid = threadIdx.x; asm volatile("" : "+v"(tid));
    for (int j = 0; j < 2; ++j) {
        conv_job(tid, t, p.in[6] + (size_t)j * 1024 * A_IN, (bf16_t*)(ws + WS_WAIN) + (size_t)j * A_IN * 1024, 1024, A_IN, p.in[3] + (2 * j) * 1024, 1);
        conv_job(tid, t, p.in[9] + (size_t)j * 1024 * B_IN, (bf16_t*)(ws + WS_WBIN) + (size_t)j * B_IN * 1024, 1024, B_IN, p.in[3] + (2 * j + 1) * 1024, 2);
        conv_job(tid, t, p.in[8] + (size_t)j * 1024 * 1024, (bf16_t*)(ws + WS_WAOUT) + (size_t)j * 1024 * 1024, 1024, 1024, nullptr, 0);
        conv_job(tid, t, p.in[14] + (size_t)j * 1024 * 1024, (bf16_t*)(ws + WS_WBOUT) + (size_t)j * 1024 * 1024, 1024, 1024, nullptr, 0);
    }
    for (int i = 0; i < 4; ++i) {
        conv_job(tid, t, p.in[15] + (size_t)i * 1024 * 512, (bf16_t*)(ws + WS_WMKV) + (size_t)i * 512 * 1024, 1024, 512, nullptr, 0);
        conv_job(tid, t, p.in[16] + (size_t)i * 1024 * GU_N, (bf16_t*)(ws + WS_WGU) + (size_t)i * GU_N * 1024, 1024, GU_N, p.in[4] + i * 1024, 3);
        conv_job(tid, t, p.in[17] + (size_t)i * DFF * 1024, (bf16_t*)(ws + WS_WDN) + (size_t)i * 1024 * DFF, DFF, 1024, nullptr, 0);
    }
    const int gtid = blockIdx.x * 512 + tid, gn = gridDim.x * 512;
    { const float* s = p.in[10]; bf16_t* d = (bf16_t*)(ws + WS_BWS);
      for (int i = gtid; i < 2 * 6 * 128 * 128; i += gn) { const int tt = (i >> 7) & 127, sidx = i & 127; const float v = (sidx <= tt) ? s[i] : 0.f; d[i] = (bf16_t)(cvt_pk_bf16(v, 0.f) & 0xffffu); } }
    { unsigned* ss = (unsigned*)(ws + WS_SS) + 65536;
      for (int i = gtid; i < 8 * 65536; i += gn) ss[i] = 0u; }
    const int gw = gtid >> 6, nw = gn >> 6, lane = tid & 63;
    { const float* mem = p.in[1]; const float* g = p.in[2]; bf16_t* mn = (bf16_t*)(ws + WS_MEMN);
      for (int row = gw; row < 2048; row += nw) {
          f32x4 v[4]; float sq = 0.f;
#pragma unroll
          for (int i = 0; i < 4; ++i) { v[i] = *(const f32x4*)(mem + (size_t)row * 1024 + i * 256 + lane * 4); sq += v[i][0] * v[i][0] + v[i][1] * v[i][1] + v[i][2] * v[i][2] + v[i][3] * v[i][3]; }
          sq = wave_sum(sq); const float rs = rsqrtf(sq * (1.f / 1024.f) + EPS);
#pragma unroll
          for (int i = 0; i < 4; ++i) { const f32x4 gg = *(const f32x4*)(g + i * 256 + lane * 4); const f32x4 o = v[i] * rs * gg;
              u32x2 pk; pk[0] = cvt_pk_bf16(o[0], o[1]); pk[1] = cvt_pk_bf16(o[2], o[3]); *(u32x2*)(mn + (size_t)row * 1024 + i * 256 + lane * 4) = pk; }
      } }
    for (int rep = 0; rep < PROBE_X; ++rep)
    { const float* x = p.in[0]; bf16_t* h16 = (bf16_t*)(ws + WS_H16); unsigned* ss0 = (unsigned*)(ws + WS_SS);
      for (int row0 = gw * 4; row0 < T_TOK; row0 += nw * 4) {
          f32x4 v[4][4];
#pragma unroll
          for (int r = 0; r < 4; ++r)
#pragma unroll
              for (int i = 0; i < 4; ++i) v[r][i] = *(const f32x4*)(x + (size_t)(row0 + r) * 1024 + i * 256 + lane * 4);
          float sq[4];
#pragma unroll
          for (int r = 0; r < 4; ++r) { sq[r] = 0.f;
#pragma unroll
              for (int i = 0; i < 4; ++i) { const f32x4 w = v[r][i]; sq[r] += w[0] * w[0] + w[1] * w[1] + w[2] * w[2] + w[3] * w[3];
                  u32x2 pk; pk[0] = cvt_pk_bf16(w[0], w[1]); pk[1] = cvt_pk_bf16(w[2], w[3]); *(u32x2*)(h16 + (size_t)(row0 + r) * 1024 + i * 256 + lane * 4) = pk; } }
#pragma unroll
          for (int o = 32; o; o >>= 1) {
#pragma unroll
              for (int r = 0; r < 4; ++r) sq[r] += __shfl_xor(sq[r], o);
          }
          if (lane < 4) ss0[row0 + lane] = (unsigned)((lane == 0 ? sq[0] : lane == 1 ? sq[1] : lane == 2 ? sq[2] : sq[3]) * SS_SCALE);
      } }
}

constexpr int KSTR = 144, VSTR = 160, K_OFF = 0, V_OFF = 256 * KSTR;
__device__ __forceinline__ s16x4 tr_read(LAS unsigned char* a) { return __builtin_amdgcn_ds_read_tr16_b64_v4i16((LAS s16x4*)a); }

template <bool SWA> __device__ __forceinline__ void attn_item(const int tid, LAS unsigned char* lds, const bf16_t* Q, int ldq, const bf16_t* Kg, const bf16_t* Vg, int ldkv, bool zfirst, float sink, bf16_t* O) {
    const int wid = __builtin_amdgcn_readfirstlane(tid >> 6), lane = tid & 63, fr = lane & 15, fq = lane >> 4;
    __syncthreads();
#pragma unroll
    for (int i = 0; i < 4; ++i) {
        const int c = tid + 512 * i, row = c >> 3, ch = c & 7;
        u32x4 kv = (u32x4){0u, 0u, 0u, 0u}, vv = (u32x4){0u, 0u, 0u, 0u};
        if (!(zfirst && i < 2)) { kv = *(const u32x4*)(Kg + (long)row * ldkv + ch * 8); vv = *(const u32x4*)(Vg + (long)row * ldkv + ch * 8); }
        *(LAS u32x4*)(lds + K_OFF + row * KSTR + ch * 16) = kv;
        *(LAS u32x4*)(lds + V_OFF + row * VSTR + ch * 16) = vv;
    }
    const bf16_t* qp = Q + (long)(16 * wid + fr) * ldq + fq * 8;
    const bf16x8 q0 = *(const bf16x8*)qp, q1 = *(const bf16x8*)(qp + 32);
    __syncthreads();
    f32x4 s[16];
#pragma unroll
    for (int sub = 0; sub < 16; ++sub) {
        s[sub] = (f32x4){0.f, 0.f, 0.f, 0.f};
        const bf16x8 a0 = *(const LAS bf16x8*)(lds + K_OFF + (16 * sub + fr) * KSTR + fq * 16);
        const bf16x8 a1 = *(const LAS bf16x8*)(lds + K_OFF + (16 * sub + fr) * KSTR + 64 + fq * 16);
        s[sub] = __builtin_amdgcn_mfma_f32_16x16x32_bf16(a0, q0, s[sub], 0, 0, 0);
        s[sub] = __builtin_amdgcn_mfma_f32_16x16x32_bf16(a1, q1, s[sub], 0, 0, 0);
    }
    const int qi = 16 * wid + fr;
    float mx = SWA ? sink : -INFINITY;
#pragma unroll
    for (int sub = 0; sub < 16; ++sub)
#pragma unroll
        for (int j = 0; j < 4; ++j) {
            if (SWA) { const int kj = 16 * sub + 4 * fq + j; const bool ok = (kj > qi) && (kj <= qi + 128) && (!zfirst || kj >= 128); if (!ok) s[sub][j] = -INFINITY; }
            mx = fmaxf(mx, s[sub][j]);
        }
    mx = xrow_max(mx);
    float sum = 0.f;
#pragma unroll
    for (int sub = 0; sub < 16; ++sub)
#pragma unroll
        for (int j = 0; j < 4; ++j) { const float e = __builtin_amdgcn_exp2f((s[sub][j] - mx) * 1.4426950408889634f); s[sub][j] = e; sum += e; }
    sum = xrow_sum(sum);
    if (SWA) sum += __builtin_amdgcn_exp2f((sink - mx) * 1.4426950408889634f);
    const float inv = 1.f / sum;
    f32x4 o[4];
#pragma unroll
    for (int d = 0; d < 4; ++d) o[d] = (f32x4){0.f, 0.f, 0.f, 0.f};
    LAS unsigned char* vb = lds + V_OFF + (4 * fq + (fr >> 2)) * VSTR + (fr & 3) * 8;
#pragma unroll
    for (int kk = 0; kk < 8; ++kk) {
        const f32x4 p0 = s[2 * kk] * inv, p1 = s[2 * kk + 1] * inv;
        u32x4 pk; pk[0] = cvt_pk_bf16(p0[0], p0[1]); pk[1] = cvt_pk_bf16(p0[2], p0[3]); pk[2] = cvt_pk_bf16(p1[0], p1[1]); pk[3] = cvt_pk_bf16(p1[2], p1[3]);
        const bf16x8 pf = __builtin_bit_cast(bf16x8, pk);
#pragma unroll
        for (int d = 0; d < 4; ++d) {
            const s16x4 v1 = tr_read(vb + (32 * kk) * VSTR + d * 32), v2 = tr_read(vb + (32 * kk + 16) * VSTR + d * 32);
            const bf16x8 vf = __builtin_shufflevector(v1, v2, 0, 1, 2, 3, 4, 5, 6, 7);
            o[d] = __builtin_amdgcn_mfma_f32_16x16x32_bf16(vf, pf, o[d], 0, 0, 0);
        }
    }
    bf16_t* op = O + (long)(16 * wid + fr) * 1024 + 4 * fq;
#pragma unroll
    for (int d = 0; d < 4; ++d) { u32x2 pk; pk[0] = cvt_pk_bf16(o[d][0], o[d][1]); pk[1] = cvt_pk_bf16(o[d][2], o[d][3]); *(u32x2*)(op + 16 * d) = pk; }
}

__device__ __forceinline__ void mem_item(const int tid, const Params& p, LAS unsigned char* lds, int layer, const bf16_t* proj, int ldp, int qoff, int qb, int mh) {
    const int b = qb >> 6; const long tok0 = (long)qb * 128;
    const bf16_t* kv = (const bf16_t*)(p.ws + WS_MEMKV) + (long)b * 256 * 2048 + layer * 512 + mh * 64;
    attn_item<false>(tid, lds, proj + tok0 * ldp + qoff + mh * 64, ldp, kv, kv + 256, 2048, false, 0.f, (bf16_t*)(p.ws + WS_MIX) + tok0 * 1024 + 768 + mh * 64);
}

struct KV8 { u32x4 k[4], v[4]; };
__device__ __forceinline__ void kv_load(KV8& r, int tid, const bf16_t* Kg, const bf16_t* Vg, int ldkv, bool zfirst) {
#pragma unroll
    for (int i = 0; i < 4; ++i) {
        const int c = tid + 512 * i, row = c >> 3, ch = c & 7;
        r.k[i] = (u32x4){0u, 0u, 0u, 0u}; r.v[i] = (u32x4){0u, 0u, 0u, 0u};
        if (!(zfirst && i < 2)) { r.k[i] = *(const u32x4*)(Kg + (long)row * ldkv + ch * 8); r.v[i] = *(const u32x4*)(Vg + (long)row * ldkv + ch * 8); }
    }
}
__device__ __forceinline__ void kv_store(LAS unsigned char* lds, int tid, const KV8& r) {
#pragma unroll
    for (int i = 0; i < 4; ++i) {
        const int c = tid + 512 * i, row = c >> 3, ch = c & 7;
        *(LAS u32x4*)(lds + K_OFF + row * KSTR + ch * 16) = r.k[i];
        *(LAS u32x4*)(lds + V_OFF + row * VSTR + ch * 16) = r.v[i];
    }
}
__device__ __forceinline__ void swa_head(const int tid, LAS unsigned char* lds, const bf16x8 (&kf)[9][2], const bf16x8 q0, const bf16x8 q1, bool zfirst, float sink, bf16_t* O) {
    const int wid = __builtin_amdgcn_readfirstlane(tid >> 6), lane = tid & 63, fr = lane & 15, fq = lane >> 4;
    f32x4 s[10];
#pragma unroll
    for (int t = 0; t < 9; ++t) {
        s[t] = (f32x4){0.f, 0.f, 0.f, 0.f};
        s[t] = __builtin_amdgcn_mfma_f32_16x16x32_bf16(kf[t][0], q0, s[t], 0, 0, 0);
        s[t] = __builtin_amdgcn_mfma_f32_16x16x32_bf16(kf[t][1], q1, s[t], 0, 0, 0);
    }
    f32x4 m4 = (f32x4){sink, sink, sink, sink};
#pragma unroll
    for (int t = 0; t < 9; ++t) {
        const bool dead = zfirst && (wid + t < 8);
#pragma unroll
        for (int j = 0; j < 4; ++j) {
            bool ok = !dead;
            if (t == 0) ok = ok && (4 * fq + j > fr);
            if (t == 8) ok = ok && (4 * fq + j <= fr);
            if (!ok) s[t][j] = -INFINITY;
            m4[j] = fmaxf(m4[j], s[t][j]);
        }
    }
    const float mx = xrow_max(fmaxf(fmaxf(m4[0], m4[1]), fmaxf(m4[2], m4[3])));
    const float nmxl = -mx * 1.4426950408889634f;
    f32x4 s4 = (f32x4){0.f, 0.f, 0.f, 0.f};
#pragma unroll
    for (int t = 0; t < 9; ++t)
#pragma unroll
        for (int j = 0; j < 4; ++j) { const float e = __builtin_amdgcn_exp2f(__builtin_fmaf(s[t][j], 1.4426950408889634f, nmxl)); s[t][j] = e; s4[j] += e; }
    float sum = xrow_sum((s4[0] + s4[1]) + (s4[2] + s4[3]));
    sum += __builtin_amdgcn_exp2f(__builtin_fmaf(sink, 1.4426950408889634f, nmxl));
    const float inv = 1.f / sum;
    s[9] = (f32x4){0.f, 0.f, 0.f, 0.f};
    f32x4 o[4];
#pragma unroll
    for (int d = 0; d < 4; ++d) o[d] = (f32x4){0.f, 0.f, 0.f, 0.f};
    LAS unsigned char* vb = lds + V_OFF + (16 * wid + 4 * fq + (fr >> 2)) * VSTR + (fr & 3) * 8;
#pragma unroll
    for (int kk = 0; kk < 5; ++kk) {
        const int t0 = 2 * kk, t1 = (kk == 4) ? 8 : 2 * kk + 1;
        const f32x4 p0 = s[2 * kk] * inv, p1 = s[2 * kk + 1] * inv;
        u32x4 pk; pk[0] = cvt_pk_bf16(p0[0], p0[1]); pk[1] = cvt_pk_bf16(p0[2], p0[3]); pk[2] = cvt_pk_bf16(p1[0], p1[1]); pk[3] = cvt_pk_bf16(p1[2], p1[3]);
        const bf16x8 pf = __builtin_bit_cast(bf16x8, pk);
#pragma unroll
        for (int d = 0; d < 4; ++d) {
            const s16x4 v1 = tr_read(vb + (16 * t0) * VSTR + d * 32), v2 = tr_read(vb + (16 * t1) * VSTR + d * 32);
            const bf16x8 vf = __builtin_shufflevector(v1, v2, 0, 1, 2, 3, 4, 5, 6, 7);
            o[d] = __builtin_amdgcn_mfma_f32_16x16x32_bf16(vf, pf, o[d], 0, 0, 0);
        }
    }
    bf16_t* op = O + (long)(16 * wid + fr) * 1024 + 4 * fq;
#pragma unroll
    for (int d = 0; d < 4; ++d) { u32x2 pk; pk[0] = cvt_pk_bf16(o[d][0], o[d][1]); pk[1] = cvt_pk_bf16(o[d][2], o[d][3]); *(u32x2*)(op + 16 * d) = pk; }
}
__device__ __forceinline__ void mem_head(const int tid, LAS unsigned char* lds, const bf16x8 q0, const bf16x8 q1, bf16_t* O) {
    const int wid = __builtin_amdgcn_readfirstlane(tid >> 6), lane = tid & 63, fr = lane & 15, fq = lane >> 4;
    f32x4 s[16];
#pragma unroll
    for (int sub = 0; sub < 16; ++sub) {
        s[sub] = (f32x4){0.f, 0.f, 0.f, 0.f};
        const bf16x8 a0 = *(const LAS bf16x8*)(lds + K_OFF + (16 * sub + fr) * KSTR + fq * 16);
        const bf16x8 a1 = *(const LAS bf16x8*)(lds + K_OFF + (16 * sub + fr) * KSTR + 64 + fq * 16);
        s[sub] = __builtin_amdgcn_mfma_f32_16x16x32_bf16(a0, q0, s[sub], 0, 0, 0);
        s[sub] = __builtin_amdgcn_mfma_f32_16x16x32_bf16(a1, q1, s[sub], 0, 0, 0);
    }
    f32x4 m4 = s[0];
#pragma unroll
    for (int sub = 1; sub < 16; ++sub)
#pragma unroll
        for (int j = 0; j < 4; ++j) m4[j] = fmaxf(m4[j], s[sub][j]);
    float mx = xrow_max(fmaxf(fmaxf(m4[0], m4[1]), fmaxf(m4[2], m4[3])));
    const float nmxl = -mx * 1.4426950408889634f;
    f32x4 s4 = (f32x4){0.f, 0.f, 0.f, 0.f};
#pragma unroll
    for (int sub = 0; sub < 16; ++sub)
#pragma unroll
        for (int j = 0; j < 4; ++j) { const float e = __builtin_amdgcn_exp2f(__builtin_fmaf(s[sub][j], 1.4426950408889634f, nmxl)); s[sub][j] = e; s4[j] += e; }
    float sum = xrow_sum((s4[0] + s4[1]) + (s4[2] + s4[3]));
    const float inv = 1.f / sum;
    f32x4 o[4];
#pragma unroll
    for (int d = 0; d < 4; ++d) o[d] = (f32x4){0.f, 0.f, 0.f, 0.f};
    LAS unsigned char* vb = lds + V_OFF + (4 * fq + (fr >> 2)) * VSTR + (fr & 3) * 8;
#pragma unroll
    for (int kk = 0; kk < 8; ++kk) {
        const f32x4 p0 = s[2 * kk] * inv, p1 = s[2 * kk + 1] * inv;
        u32x4 pk; pk[0] = cvt_pk_bf16(p0[0], p0[1]); pk[1] = cvt_pk_bf16(p0[2], p0[3]); pk[2] = cvt_pk_bf16(p1[0], p1[1]); pk[3] = cvt_pk_bf16(p1[2], p1[3]);
        const bf16x8 pf = __builtin_bit_cast(bf16x8, pk);
#pragma unroll
        for (int d = 0; d < 4; ++d) {
            const s16x4 v1 = tr_read(vb + (32 * kk) * VSTR + d * 32), v2 = tr_read(vb + (32 * kk + 16) * VSTR + d * 32);
            const bf16x8 vf = __builtin_shufflevector(v1, v2, 0, 1, 2, 3, 4, 5, 6, 7);
            o[d] = __builtin_amdgcn_mfma_f32_16x16x32_bf16(vf, pf, o[d], 0, 0, 0);
        }
    }
    bf16_t* op = O + (long)(16 * wid + fr) * 1024 + 4 * fq;
#pragma unroll
    for (int d = 0; d < 4; ++d) { u32x2 pk; pk[0] = cvt_pk_bf16(o[d][0], o[d][1]); pk[1] = cvt_pk_bf16(o[d][2], o[d][3]); *(u32x2*)(op + 16 * d) = pk; }
}
struct AItem { int qb, sel; bool zf; const bf16_t* Kg; const bf16_t* Vg; int ldkv; };
__device__ __forceinline__ bool a_item(const Params& p, int layer, int n, AItem& it) {
    const int k = n >> 1; it.sel = n & 1; it.qb = (int)blockIdx.x + k * (int)gridDim.x;
    if (it.qb >= 512) return false;
    const long tok0 = (long)it.qb * 128;
    it.Kg = (const bf16_t*)(p.ws + WS_BIG) + (size_t)(12 + it.sel) * T_TOK * 64 + (tok0 - 128) * 64; it.Vg = it.Kg + (size_t)2 * T_TOK * 64; it.ldkv = 64; it.zf = (it.qb & 63) == 0;
    return true;
}
__device__ __forceinline__ void mem_part(const int tid_in, const Params& p, LAS unsigned char* lds, int layer, const bf16_t* qbase) {
    int tid = tid_in; asm volatile("" : "+v"(tid));
    const int wid = __builtin_amdgcn_readfirstlane(tid >> 6), lane = tid & 63, fr = lane & 15, fq = lane >> 4;
    const long qlane = (long)(16 * wid + fr) * 64 + fq * 8;
    bf16_t* mix = (bf16_t*)(p.ws + WS_MIX);
    for (int pi = blockIdx.x; pi < 256; pi += gridDim.x) {
        const int combo = pi & 31, slice = pi >> 5, b = combo >> 2, mh = combo & 3;
        const bf16_t* kg = (const bf16_t*)(p.ws + WS_MEMKV) + (long)b * 256 * 2048 + layer * 512 + mh * 64;
        int t2 = tid; asm volatile("" : "+v"(t2));
        KV8 r; kv_load(r, t2, kg, kg + 256, 2048, false);
        const int qb0 = b * 64 + slice * 8;
        bf16x8 qn0, qn1;
        const bf16_t* qh = qbase + (size_t)mh * T_TOK * 64 + qlane;
        { const bf16_t* qp = qh + (long)qb0 * 128 * 64; qn0 = *(const bf16x8*)qp; qn1 = *(const bf16x8*)(qp + 32); }
        __syncthreads();
        kv_store(lds, t2, r);
        __syncthreads();
#pragma nounroll
        for (int i = 0; i < 8; ++i) {
            const bf16x8 q0 = qn0, q1 = qn1;
            if (i + 1 < 8) { const bf16_t* qp = qh + (long)(qb0 + i + 1) * 128 * 64; qn0 = *(const bf16x8*)qp; qn1 = *(const bf16x8*)(qp + 32); }
            mem_head(tid, lds, q0, q1, mix + (long)(qb0 + i) * 128 * 1024 + 768 + mh * 64);
        }
    }
}
__device__ void mix_phase_a(const Params& p, LAS unsigned char* lds, int layer) {
    int tid = threadIdx.x; asm volatile("" : "+v"(tid));
    const int j = layer >> 1;
    const bf16_t* proj = (const bf16_t*)(p.ws + WS_BIG);
    bf16_t* mix = (bf16_t*)(p.ws + WS_MIX);
    const float* sinks = p.in[7] + j * 12;
    const int wid = __builtin_amdgcn_readfirstlane(tid >> 6), lane = tid & 63, fr = lane & 15, fq = lane >> 4;
    const long qlane = (long)(16 * wid + fr) * 64 + fq * 8;
    const int nqb = (512 - (int)blockIdx.x + (int)gridDim.x - 1) / (int)gridDim.x, nh = 12 * nqb;
    KV8 r; AItem it; bf16x8 kf[9][2];
    if (nh > 0) { a_item(p, layer, 0, it); kv_load(r, tid, it.Kg, it.Vg, it.ldkv, it.zf); }
    bf16x8 qn0, qn1;
    if (nh > 0) { const bf16_t* qp = proj + (long)blockIdx.x * 128 * 64 + qlane; qn0 = *(const bf16x8*)qp; qn1 = *(const bf16x8*)(qp + 32); }
    for (int g = 0; g < nh; ++g) {
        const int k = g / 12, hh = g - 12 * k, qb = (int)blockIdx.x + k * (int)gridDim.x;
        const bool zf = (qb & 63) == 0;
        if (hh == 0 || hh == 6) {
            __syncthreads();
            kv_store(lds, tid, r);
            __syncthreads();
            const int gi = (hh < 6) ? 0 : 1;
            if (a_item(p, layer, 2 * k + gi + 1, it)) kv_load(r, tid, it.Kg, it.Vg, it.ldkv, it.zf);
            {
                LAS unsigned char* kb = lds + K_OFF + (16 * wid + fr) * KSTR + fq * 16;
#pragma unroll
                for (int t = 0; t < 9; ++t) { kf[t][0] = *(const LAS bf16x8*)(kb + t * 16 * KSTR); kf[t][1] = *(const LAS bf16x8*)(kb + t * 16 * KSTR + 64); }
            }
        }
        const bf16x8 q0 = qn0, q1 = qn1;
        if (g + 1 < nh) { const int g1 = g + 1, k1 = g1 / 12, hh1 = g1 - 12 * k1, qb1 = (int)blockIdx.x + k1 * (int)gridDim.x;
            const bf16_t* qp = proj + (size_t)hh1 * T_TOK * 64 + (long)qb1 * 128 * 64 + qlane; qn0 = *(const bf16x8*)qp; qn1 = *(const bf16x8*)(qp + 32); }
        bf16_t* O = mix + (long)qb * 128 * 1024 + hh * 64;
        swa_head(tid, lds, kf, q0, q1, zf, sinks[hh], O);
    }
    mem_part(tid, p, lds, layer, proj + (size_t)16 * T_TOK * 64);
}

constexpr int NSTR = 288;
__device__ void mix_phase_b(const Params& p, LAS unsigned char* lds, int layer) {
    int tid = threadIdx.x; asm volatile("" : "+v"(tid));
    const int j = layer >> 1;
    const bf16_t* proj = (const bf16_t*)(p.ws + WS_BIG);
    bf16_t* mix = (bf16_t*)(p.ws + WS_MIX);
    const int wid = __builtin_amdgcn_readfirstlane(tid >> 6), lane = tid & 63, fr = lane & 15, fq = lane >> 4;
    {
        const int NI = 512 * 6;
        u32x4 vr[4];
        f32x4 g0, g1, b0, b1;
        const int lrow = tid >> 4, lch = tid & 15;
        int item = blockIdx.x;
        if (item < NI) { const int cb = item / 6, g = item - 6 * cb;
#pragma unroll
            for (int i = 0; i < 4; ++i) vr[i] = *(const u32x4*)(proj + (size_t)(6 + g) * T_TOK * 128 + ((long)cb * 128 + lrow + 32 * i) * 128 + lch * 8);
            const float* lng = p.in[12] + (j * 6 + g) * 128 + lch * 8; const float* lnb = p.in[13] + (j * 6 + g) * 128 + lch * 8;
            g0 = *(const f32x4*)lng; g1 = *(const f32x4*)(lng + 4); b0 = *(const f32x4*)lnb; b1 = *(const f32x4*)(lnb + 4); }
        for (; item < NI; item += gridDim.x) {
            const int cb = item / 6, g = item - 6 * cb; const long tok0 = (long)cb * 128;
            const int t = 16 * wid + fr;
            const bf16_t* W = (const bf16_t*)(p.ws + WS_BWS) + (size_t)(j * 6 + g) * 128 * 128 + t * 128 + 4 * fq;
            const int nks = (wid >> 1) + 1;
            u32x2 w0[4], w1[4];
#pragma unroll
            for (int ks = 0; ks < 4; ++ks) { w0[ks] = (u32x2){0u, 0u}; w1[ks] = (u32x2){0u, 0u}; if (ks < nks) { w0[ks] = *(const u32x2*)(W + 32 * ks); w1[ks] = *(const u32x2*)(W + 32 * ks + 16); } }
            const float bias = p.in[11][(j * 6 + g) * 128 + t];
            const bf16_t* up = proj + (size_t)g * T_TOK * 128 + (tok0 + t) * 128 + 4 * fq;
            u32x2 ur[8];
#pragma unroll
            for (int d = 0; d < 8; ++d) ur[d] = *(const u32x2*)(up + 16 * d);
            __syncthreads();
#pragma unroll
            for (int i = 0; i < 4; ++i) {
                const u32x4 raw = vr[i];
                float v[8];
#pragma unroll
                for (int e = 0; e < 4; ++e) { v[2 * e] = __uint_as_float(raw[e] << 16); v[2 * e + 1] = __uint_as_float(raw[e] & 0xffff0000u); }
                float sm = 0.f, sq = 0.f;
#pragma unroll
                for (int e = 0; e < 8; ++e) { sm += v[e]; sq += v[e] * v[e]; }
                sm = row16_sum(sm); sq = row16_sum(sq);
                const float mu = sm * (1.f / 128.f);
                const float rs = rsqrtf(fmaxf(sq * (1.f / 128.f) - mu * mu, 0.f) + EPS);
#pragma unroll
                for (int e = 0; e < 8; ++e) v[e] -= mu;
                u32x4 pk;
                pk[0] = cvt_pk_bf16(v[0] * rs * g0[0] + b0[0], v[1] * rs * g0[1] + b0[1]); pk[1] = cvt_pk_bf16(v[2] * rs * g0[2] + b0[2], v[3] * rs * g0[3] + b0[3]);
                pk[2] = cvt_pk_bf16(v[4] * rs * g1[0] + b1[0], v[5] * rs * g1[1] + b1[1]); pk[3] = cvt_pk_bf16(v[6] * rs * g1[2] + b1[2], v[7] * rs * g1[3] + b1[3]);
                *(LAS u32x4*)(lds + (lrow + 32 * i) * NSTR + lch * 16) = pk;
            }
            __syncthreads();
            { const int nitem = item + gridDim.x;
              if (nitem < NI) { const int ncb = nitem / 6, ng = nitem - 6 * ncb;
#pragma unroll
                  for (int i = 0; i < 4; ++i) vr[i] = *(const u32x4*)(proj + (size_t)(6 + ng) * T_TOK * 128 + ((long)ncb * 128 + lrow + 32 * i) * 128 + lch * 8);
                  const float* lng = p.in[12] + (j * 6 + ng) * 128 + lch * 8; const float* lnb = p.in[13] + (j * 6 + ng) * 128 + lch * 8;
                  g0 = *(const f32x4*)lng; g1 = *(const f32x4*)(lng + 4); b0 = *(const f32x4*)lnb; b1 = *(const f32x4*)(lnb + 4); } }
            f32x4 acc[8];
#pragma unroll
            for (int d = 0; d < 8; ++d) acc[d] = (f32x4){0.f, 0.f, 0.f, 0.f};
            LAS unsigned char* vb = lds + (4 * fq + (fr >> 2)) * NSTR + (fr & 3) * 8;
#pragma unroll
            for (int ks = 0; ks < 4; ++ks) {
                if (ks < nks) {
                    u32x4 wp; wp[0] = w0[ks][0]; wp[1] = w0[ks][1]; wp[2] = w1[ks][0]; wp[3] = w1[ks][1];
                    const bf16x8 wf = __builtin_bit_cast(bf16x8, wp);
#pragma unroll
                    for (int d = 0; d < 8; ++d) {
                        const s16x4 v1 = tr_read(vb + (32 * ks) * NSTR + d * 32), v2 = tr_read(vb + (32 * ks + 16) * NSTR + d * 32);
                        const bf16x8 vf = __builtin_shufflevector(v1, v2, 0, 1, 2, 3, 4, 5, 6, 7);
                        acc[d] = __builtin_amdgcn_mfma_f32_16x16x32_bf16(vf, wf, acc[d], 0, 0, 0);
                    }
                }
            }
            bf16_t* op = mix + (tok0 + t) * 1024 + 128 * g + 4 * fq;
#pragma unroll
            for (int d = 0; d < 8; ++d) {
                const float u0 = __uint_as_float(ur[d][0] << 16), u1 = __uint_as_float(ur[d][0] & 0xffff0000u), u2 = __uint_as_float(ur[d][1] << 16), u3 = __uint_as_float(ur[d][1] & 0xffff0000u);
                u32x2 pk; pk[0] = cvt_pk_bf16(u0 * (acc[d][0] + bias), u1 * (acc[d][1] + bias)); pk[1] = cvt_pk_bf16(u2 * (acc[d][2] + bias), u3 * (acc[d][3] + bias));
                *(u32x2*)(op + 16 * d) = pk;
            }
        }
    }
    mem_part(tid, p, lds, layer, proj + (size_t)12 * T_TOK * 128);
}

__device__ void final_phase(const Params& p) {
    int tid = threadIdx.x; asm volatile("" : "+v"(tid));
    const int gw = (blockIdx.x * 512 + tid) >> 6, nw = (gridDim.x * 512) >> 6, lane = tid & 63;
    const unsigned* ss = (const unsigned*)(p.ws + WS_SS) + 8 * 65536; const float* g = p.in[5];
    const bf16_t* h16 = (const bf16_t*)(p.ws + WS_H16);
    const f32x4 g0 = *(const f32x4*)(g + lane * 8), g1 = *(const f32x4*)(g + lane * 8 + 4), g2 = *(const f32x4*)(g + 512 + lane * 8), g3 = *(const f32x4*)(g + 512 + lane * 8 + 4);
    for (int row0 = gw * 4; row0 < T_TOK; row0 += nw * 4) {
        u32x4 a[4], b[4]; unsigned sv[4];
#pragma unroll
        for (int r = 0; r < 4; ++r) { const int row = row0 + r; a[r] = *(const u32x4*)(h16 + (size_t)row * 1024 + lane * 8); b[r] = *(const u32x4*)(h16 + (size_t)row * 1024 + 512 + lane * 8); sv[r] = ss[row]; }
#pragma unroll
        for (int r = 0; r < 4; ++r) { const int row = row0 + r;
            const float rs = rsqrtf((float)sv[r] * SS_INV + EPS);
            f32x4 v0, v1, v2, v3;
            v0[0] = __uint_as_float(a[r][0] << 16); v0[1] = __uint_as_float(a[r][0] & 0xffff0000u); v0[2] = __uint_as_float(a[r][1] << 16); v0[3] = __uint_as_float(a[r][1] & 0xffff0000u);
            v1[0] = __uint_as_float(a[r][2] << 16); v1[1] = __uint_as_float(a[r][2] & 0xffff0000u); v1[2] = __uint_as_float(a[r][3] << 16); v1[3] = __uint_as_float(a[r][3] & 0xffff0000u);
            v2[0] = __uint_as_float(b[r][0] << 16); v2[1] = __uint_as_float(b[r][0] & 0xffff0000u); v2[2] = __uint_as_float(b[r][1] << 16); v2[3] = __uint_as_float(b[r][1] & 0xffff0000u);
            v3[0] = __uint_as_float(b[r][2] << 16); v3[1] = __uint_as_float(b[r][2] & 0xffff0000u); v3[2] = __uint_as_float(b[r][3] << 16); v3[3] = __uint_as_float(b[r][3] & 0xffff0000u);
            float* o = p.out + (size_t)row * 1024 + lane * 8;
            *(f32x4*)o = v0 * rs * g0; *(f32x4*)(o + 4) = v1 * rs * g1; *(f32x4*)(o + 512) = v2 * rs * g2; *(f32x4*)(o + 516) = v3 * rs * g3;
        }
    }
}

__device__ __forceinline__ void run_phase(const Params& p, LAS unsigned char* lds, int ph) {
    unsigned char* ws = p.ws;
    unsigned* ss = (unsigned*)(ws + WS_SS);
    bf16_t* h16 = (bf16_t*)(ws + WS_H16);
    bf16_t* big = (bf16_t*)(ws + WS_BIG);
    bf16_t* mix = (bf16_t*)(ws + WS_MIX);
    if (ph == 0) { for (int rep = 0; rep < PROBE_P0; ++rep) prologue(p, lds); return; }
    if (ph == 1) { EpiProj<2> E; E.O = (bf16_t*)(ws + WS_MEMKV); E.ldc = 2048; E.ss = nullptr;
        run_gemm(lds, (const bf16_t*)(ws + WS_MEMN), (const bf16_t*)(ws + WS_WMKV), 2048, 2048, 1024, E); return; }
    if (ph == NPH - 1) { final_phase(p); return; }
    const int layer = (ph - 2) / 5, sub = (ph - 2) % 5, j = layer >> 1; const bool isB = layer & 1;
    if (sub == 0) {
        if (!isB) { EpiProj<0> E; E.O = big; E.ldc = A_IN; E.ss = ss + (2 * layer) * 65536;
            run_gemm(lds, h16, (const bf16_t*)(ws + WS_WAIN) + (size_t)j * A_IN * 1024, T_TOK, A_IN, 1024, E); }
        else { EpiProj<1> E; E.O = big; E.ldc = B_IN; E.ss = ss + (2 * layer) * 65536;
            run_gemm(lds, h16, (const bf16_t*)(ws + WS_WBIN) + (size_t)j * B_IN * 1024, T_TOK, B_IN, 1024, E); }
    } else if (sub == 1) {
        for (int rep = 0; rep < PROBE_MIX; ++rep) { if (!isB) mix_phase_a(p, lds, layer); else mix_phase_b(p, lds, layer); }
    } else if (sub == 2) {
        const bf16_t* wo = (const bf16_t*)(ws + (isB ? WS_WBOUT : WS_WAOUT)) + (size_t)j * 1024 * 1024;
        if (layer == 0) { EpiRes<1, false> E; E.x = p.in[0]; E.hout = p.out; E.h16 = h16; E.ssout = ss + (2 * layer + 1) * 65536; run_gemm(lds, mix, wo, T_TOK, 1024, 1024, E); }
        else { EpiRes<0, false> E; E.x = nullptr; E.hout = p.out; E.h16 = h16; E.ssout = ss + (2 * layer + 1) * 65536; run_gemm(lds, mix, wo, T_TOK, 1024, 1024, E); }
    } else if (sub == 3) {
        EpiGateUp E; E.O = big; E.ss = ss + (2 * layer + 1) * 65536;
        run_gemm(lds, h16, (const bf16_t*)(ws + WS_WGU) + (size_t)layer * GU_N * 1024, T_TOK, GU_N, 1024, E);
    } else {
        const bf16_t* wd = (const bf16_t*)(ws + WS_WDN) + (size_t)layer * 1024 * DFF;
        { EpiRes<0, false> E; E.x = nullptr; E.hout = p.out; E.h16 = h16; E.ssout = ss + (2 * layer + 2) * 65536; run_gemm(lds, big, wd, T_TOK, 1024, DFF, E); }
    }
}

__global__ void __launch_bounds__(512, 2) mega(Params p) {
    extern __shared__ __attribute__((aligned(16))) unsigned char shm[];
    LAS unsigned char* lds = (LAS unsigned char*)shm;
    volatile LAS unsigned* st = (volatile LAS unsigned*)(lds + LDS_STAGE);
    if (threadIdx.x < 4) st[threadIdx.x] = 0u;
    __syncthreads();
    XcdBarrier bar = xcd_barrier_post((unsigned*)(p.ws + WS_BAR), st);
#pragma unroll
    for (int ph = 0; ph < NPH; ++ph) {
        if (ph >= p.ph_lo && ph < p.ph_hi) {
            if (ph > p.ph_lo) { if (p.ph_hi > NPH) cg::this_grid().sync(); else xcd_barrier(bar); }
            run_phase(p, lds, ph);
        }
    }
}

#ifndef MK_SPLIT
#define MK_SPLIT 0
#endif
extern "C" void kernel_launch(void* const* d_in, const int* in_sizes, int n_in, void* d_out, int out_size, void* d_ws, size_t ws_size, hipStream_t stream) {
    static int grid = 0;
    if (grid == 0) {
        int dev = 0, cus = 0, per_cu = 0;
        hipGetDevice(&dev);
        hipDeviceGetAttribute(&cus, hipDeviceAttributeMultiprocessorCount, dev);
        if (hipFuncSetAttribute((const void*)mega, hipFuncAttributeMaxDynamicSharedMemorySize, LDS_BYTES) != hipSuccess) fprintf(stderr, "kernel_launch: hipFuncSetAttribute failed\n");
        if (hipOccupancyMaxActiveBlocksPerMultiprocessor(&per_cu, (const void*)mega, 512, LDS_BYTES) != hipSuccess || per_cu < 1) { fprintf(stderr, "kernel_launch: occupancy query says %d\n", per_cu); per_cu = 1; }
        (void)hipGetLastError();
        grid = cus * per_cu;
        if (ws_size < WS_TOTAL) fprintf(stderr, "kernel_launch: workspace too small: %zu < %zu\n", ws_size, (size_t)WS_END);
    }
    hipMemsetAsync((char*)d_ws + WS_BAR, 0, XCD_BAR_WORDS * 4, stream);
    Params p{};
    for (int i = 0; i < 18; ++i) p.in[i] = (const float*)d_in[i];
    p.out = (float*)d_out; p.ws = (unsigned char*)d_ws;
#if MK_SPLIT
    for (int ph = 0; ph < NPH; ++ph) { p.ph_lo = ph; p.ph_hi = ph + 1; hipLaunchKernelGGL(mega, dim3(grid), dim3(512), LDS_BYTES, stream, p); }
#else
    p.ph_lo = 0; p.ph_hi = NPH;
    void* args[] = {&p};
    hipError_t e = hipLaunchCooperativeKernel((const void*)mega, dim3(grid), dim3(512), args, LDS_BYTES, stream);
    if (e != hipSuccess) fprintf(stderr, "cooperative launch failed: %s (grid %d)\n", hipGetErrorString(e), grid);
#endif
}
```
